# Optimizing an MI355X kernel written in HIP

```python
import jax, jax.numpy as jnp
from jax import lax
import numpy as np

D_MODEL = 1024
BATCH = 8
SEQ = 4096
DEPTH = 4

EPS = 1e-6
D_FF = 2816
HEAD_DIM = 64
CONV_DIM = D_MODEL // 2
CONV_WIDTH = 3
NSA_HEADS = (D_MODEL // 2) // HEAD_DIM
NSA_KV_HEADS = NSA_HEADS // 4
NSA_GROUP = NSA_HEADS // NSA_KV_HEADS
NSA_Q_DIM = NSA_HEADS * HEAD_DIM
NSA_KV_DIM = NSA_KV_HEADS * HEAD_DIM
CMP_BLOCK = 32
CMP_STRIDE = 16
CMP_HIDDEN = 128
SEL_BLOCK = 64
SEL_TOPK = 16
WINDOW = 512
NSA_Q_BLOCK = 64
FORCE_BONUS = 1e4
SB_HEADS = D_MODEL // HEAD_DIM
SB_DIM = SB_HEADS * HEAD_DIM
SB_Q_BLOCK = 128
AB_SPLITS = [CONV_DIM] * 3 + [NSA_Q_DIM] + [NSA_KV_DIM] * 6 + [3 * NSA_HEADS]
AB_IN_DIM = sum(AB_SPLITS)
AB_OUT_DIM = CONV_DIM + NSA_Q_DIM
NEG = -1e30

kernel_name = 'hybrid_conv_nsa_stickbreak_macaron'


def rms_norm(x, g):
    xf = x.astype(jnp.float32)
    y = xf * lax.rsqrt(jnp.mean(xf * xf, axis=-1, keepdims=True) + EPS)
    return (y * g.astype(jnp.float32)).astype(x.dtype)


def swiglu(x, w_in, w_out):
    gate, up = jnp.split(x @ w_in, 2, axis=-1)
    return (jax.nn.silu(gate) * up) @ w_out


def masked_softmax(s, mask):
    p = jax.nn.softmax(jnp.where(mask, s, NEG), axis=-1)
    return jnp.where(mask, p, 0.0)


def short_conv(b_gate, c_gate, h, conv_w):
    u = c_gate * h
    y = lax.conv_general_dilated(
        u, conv_w[:, None, :].astype(u.dtype), window_strides=(1,),
        padding=[(CONV_WIDTH - 1, 0)], dimension_numbers=('NWC', 'WIO', 'NWC'),
        feature_group_count=u.shape[-1])
    return b_gate * y


def compress_blocks(kv, pe, w1, w2):
    B, T, G, d = kv.shape
    nc = (T - CMP_BLOCK) // CMP_STRIDE + 1
    idx = jnp.arange(nc)[:, None] * CMP_STRIDE + jnp.arange(CMP_BLOCK)[None, :]
    blocks = kv[:, idx] + pe[:, None, :]
    flat = blocks.transpose(0, 1, 3, 2, 4).reshape(B, nc, G, CMP_BLOCK * d)
    return jax.nn.gelu(flat @ w1) @ w2


def cmp_to_sel_overlap(nc, ns):
    c0 = jnp.arange(nc) * CMP_STRIDE
    s0 = jnp.arange(ns) * SEL_BLOCK
    lo = jnp.maximum(c0[:, None], s0[None, :])
    hi = jnp.minimum(c0[:, None] + CMP_BLOCK, s0[None, :] + SEL_BLOCK)
    return jnp.maximum(hi - lo, 0).astype(jnp.float32) / CMP_BLOCK


def nsa_attention(q, kc, vc, ks, vs, kw, vw, gates):
    B, T, G, R, d = q.shape
    scale = d ** -0.5
    nc = kc.shape[1]
    ns = T // SEL_BLOCK
    topk = min(SEL_TOPK, ns)
    cmp_end = jnp.arange(nc) * CMP_STRIDE + CMP_BLOCK - 1
    overlap = cmp_to_sel_overlap(nc, ns)
    ks_blk = ks.reshape(B, ns, SEL_BLOCK, G, d).transpose(0, 3, 1, 2, 4)
    vs_blk = vs.reshape(B, ns, SEL_BLOCK, G, d).transpose(0, 3, 1, 2, 4)
    pad = ((0, 0), (WINDOW, 0), (0, 0), (0, 0))
    kw_pad = jnp.pad(kw, pad)
    vw_pad = jnp.pad(vw, pad)
    b_idx = jnp.arange(B)[:, None, None, None]
    g_idx = jnp.arange(G)[None, :, None, None]
    blk = jnp.arange(ns)
    n_sel = topk * SEL_BLOCK

    def block(n):
        start = n * NSA_Q_BLOCK
        qb = lax.dynamic_slice_in_dim(q, start, NSA_Q_BLOCK, axis=1)
        gb = lax.dynamic_slice_in_dim(gates, start, NSA_Q_BLOCK, axis=1)
        pos = start + jnp.arange(NSA_Q_BLOCK)
        s = jnp.einsum('bqgrd,bcgd->bgrqc', qb, kc, preferred_element_type=jnp.float32) * scale
        p_cmp = masked_softmax(s, cmp_end[None, :] <= pos[:, None])
        o_cmp = jnp.einsum('bgrqc,bcgd->bqgrd', p_cmp.astype(vc.dtype), vc)
        imp = jnp.einsum('bgrqc,cs->bgqs', p_cmp, overlap)
        cur = pos[:, None] // SEL_BLOCK
        forced = (blk[None, :] == 0) | (blk[None, :] == cur) | (blk[None, :] == cur - 1)
        valid = blk[None, :] * SEL_BLOCK <= pos[:, None]
        score = jnp.where(valid, imp + jnp.where(forced, FORCE_BONUS, 0.0), NEG)
        _, sel = lax.top_k(score, topk)
        k_sel = ks_blk[b_idx, g_idx, sel].reshape(B, G, NSA_Q_BLOCK, n_sel, d)
        v_sel = vs_blk[b_idx, g_idx, sel].reshape(B, G, NSA_Q_BLOCK, n_sel, d)
        key_pos = (sel[..., None] * SEL_BLOCK + jnp.arange(SEL_BLOCK)).reshape(B, G, NSA_Q_BLOCK, n_sel)
        s = jnp.einsum('bqgrd,bgqnd->bgrqn', qb, k_sel, preferred_element_type=jnp.float32) * scale
        p = masked_softmax(s, (key_pos <= pos[None, None, :, None])[:, :, None])
        o_sel = jnp.einsum('bgrqn,bgqnd->bqgrd', p.astype(v_sel.dtype), v_sel)
        kwb = lax.dynamic_slice_in_dim(kw_pad, start, WINDOW + NSA_Q_BLOCK, axis=1)
        vwb = lax.dynamic_slice_in_dim(vw_pad, start, WINDOW + NSA_Q_BLOCK, axis=1)
        kp = start - WINDOW + jnp.arange(WINDOW + NSA_Q_BLOCK)
        wmask = (kp[None, :] <= pos[:, None]) & (kp[None, :] > pos[:, None] - WINDOW) & (kp[None, :] >= 0)
        s = jnp.einsum('bqgrd,bkgd->bgrqk', qb, kwb, preferred_element_type=jnp.float32) * scale
        p = masked_softmax(s, wmask)
        o_win = jnp.einsum('bgrqk,bkgd->bqgrd', p.astype(vwb.dtype), vwb)
        return gb[..., 0:1] * o_cmp + gb[..., 1:2] * o_sel + gb[..., 2:3] * o_win

    out = lax.map(block, jnp.arange(T // NSA_Q_BLOCK))
    return jnp.moveaxis(out, 0, 1).reshape(B, T, G * R * d)


def conv_nsa_mixer(h, w_in, conv_w, pe_k, w1_k, w2_k, pe_v, w1_v, w2_v, w_out):
    B, T, _ = h.shape
    offs = np.cumsum(AB_SPLITS)[:-1].tolist()
    (b_gate, c_gate, hc, q, k_cmp, v_cmp, k_sel, v_sel, k_win, v_win,
     g) = jnp.split(h @ w_in, offs, axis=-1)
    y_conv = short_conv(b_gate, c_gate, hc, conv_w)
    kvs = lambda t: t.reshape(B, T, NSA_KV_HEADS, HEAD_DIM)
    kc = compress_blocks(kvs(k_cmp), pe_k, w1_k, w2_k)
    vc = compress_blocks(kvs(v_cmp), pe_v, w1_v, w2_v)
    qh = q.reshape(B, T, NSA_KV_HEADS, NSA_GROUP, HEAD_DIM)
    gates = jax.nn.sigmoid(g).reshape(B, T, NSA_KV_HEADS, NSA_GROUP, 3)
    y_nsa = nsa_attention(qh, kc, vc, kvs(k_sel), kvs(v_sel), kvs(k_win), kvs(v_win), gates)
    return jnp.concatenate([y_conv, y_nsa], axis=-1) @ w_out


def stick_breaking_attention(q, k, v):
    B, T, H, d = q.shape
    scale = d ** -0.5
    kpos = jnp.arange(T)

    def block(n):
        start = n * SB_Q_BLOCK
        qb = lax.dynamic_slice_in_dim(q, start, SB_Q_BLOCK, axis=1)
        qpos = start + jnp.arange(SB_Q_BLOCK)
        z = jnp.einsum('bqhd,bkhd->bhqk', qb, k, preferred_element_type=jnp.float32) * scale
        mask = kpos[None, :] < qpos[:, None]
        log_stay = jnp.where(mask, jax.nn.log_sigmoid(-z), 0.0)
        between = lax.cumsum(log_stay, axis=3, reverse=True) - log_stay
        a = jnp.where(mask, jnp.exp(jax.nn.log_sigmoid(z) + between), 0.0)
        return jnp.einsum('bhqk,bkhd->bqhd', a.astype(v.dtype), v)

    out = lax.map(block, jnp.arange(T // SB_Q_BLOCK))
    return jnp.moveaxis(out, 0, 1).reshape(B, T, H * d)


def stick_breaking_mixer(h, w_qkv, w_out):
    B, T, _ = h.shape
    q, k, v = jnp.split(h @ w_qkv, 3, axis=-1)
    hd = lambda t: t.reshape(B, T, SB_HEADS, HEAD_DIM)
    return stick_breaking_attention(hd(q), hd(k), hd(v)) @ w_out


def setup_inputs(seed: int = 0) -> dict:
    key = jax.random.key(seed)
    k = jax.random.split(key, 20)
    n_even = (DEPTH + 1) // 2
    n_odd = DEPTH // 2
    nrm = lambda i, shape, s: jax.random.normal(k[i], shape, jnp.float32) * s
    gain = lambda i, shape: 1.0 + 0.02 * jax.random.normal(k[i], shape, jnp.float32)
    L = CMP_BLOCK * HEAD_DIM
    return {
        'x': nrm(0, (BATCH, SEQ, D_MODEL), 1.0),
        'norm_ffn1': gain(1, (DEPTH, D_MODEL)),
        'w_ffn1_in': nrm(2, (DEPTH, D_MODEL, 2 * D_FF), D_MODEL ** -0.5),
        'w_ffn1_out': nrm(3, (DEPTH, D_FF, D_MODEL), D_FF ** -0.5),
        'norm_mix': gain(4, (DEPTH, D_MODEL)),
        'w_in_ab': nrm(5, (n_even, D_MODEL, AB_IN_DIM), D_MODEL ** -0.5),
        'conv_w': nrm(6, (n_even, CONV_WIDTH, CONV_DIM), CONV_WIDTH ** -0.5),
        'cmp_pe_k': nrm(7, (n_even, CMP_BLOCK, HEAD_DIM), 0.1),
        'cmp_w1_k': nrm(8, (n_even, L, CMP_HIDDEN), L ** -0.5),
        'cmp_w2_k': nrm(9, (n_even, CMP_HIDDEN, HEAD_DIM), CMP_HIDDEN ** -0.5),
        'cmp_pe_v': nrm(10, (n_even, CMP_BLOCK, HEAD_DIM), 0.1),
        'cmp_w1_v': nrm(11, (n_even, L, CMP_HIDDEN), L ** -0.5),
        'cmp_w2_v': nrm(12, (n_even, CMP_HIDDEN, HEAD_DIM), CMP_HIDDEN ** -0.5),
        'w_out_ab': nrm(13, (n_even, AB_OUT_DIM, D_MODEL), AB_OUT_DIM ** -0.5),
        'w_qkv_sb': nrm(14, (n_odd, D_MODEL, 3 * SB_DIM), D_MODEL ** -0.5),
        'w_out_sb': nrm(15, (n_odd, SB_DIM, D_MODEL), SB_DIM ** -0.5),
        'norm_ffn2': gain(16, (DEPTH, D_MODEL)),
        'w_ffn2_in': nrm(17, (DEPTH, D_MODEL, 2 * D_FF), D_MODEL ** -0.5),
        'w_ffn2_out': nrm(18, (DEPTH, D_FF, D_MODEL), D_FF ** -0.5),
        'norm_final': gain(19, (D_MODEL,)),
    }


def reference(x, norm_ffn1, w_ffn1_in, w_ffn1_out, norm_mix, w_in_ab, conv_w,
              cmp_pe_k, cmp_w1_k, cmp_w2_k, cmp_pe_v, cmp_w1_v, cmp_w2_v, w_out_ab,
              w_qkv_sb, w_out_sb, norm_ffn2, w_ffn2_in, w_ffn2_out, norm_final):
    for layer in range(DEPTH):
        x = x + 0.5 * swiglu(rms_norm(x, norm_ffn1[layer]), w_ffn1_in[layer], w_ffn1_out[layer])
        h = rms_norm(x, norm_mix[layer])
        i = layer // 2
        if layer % 2 == 0:
            x = x + conv_nsa_mixer(h, w_in_ab[i], conv_w[i], cmp_pe_k[i], cmp_w1_k[i],
                                   cmp_w2_k[i], cmp_pe_v[i], cmp_w1_v[i], cmp_w2_v[i],
                                   w_out_ab[i])
        else:
            x = x + stick_breaking_mixer(h, w_qkv_sb[i], w_out_sb[i])
        x = x + 0.5 * swiglu(rms_norm(x, norm_ffn2[layer]), w_ffn2_in[layer], w_ffn2_out[layer])
    return rms_norm(x, norm_final)
```

```cpp
#include <hip/hip_runtime.h>
#include <hip/hip_cooperative_groups.h>
#include <cstdio>
#include <cstdint>
namespace cg = cooperative_groups;

typedef unsigned short bf16_t;
typedef short bf16x8 __attribute__((ext_vector_type(8)));
typedef float f32x16 __attribute__((ext_vector_type(16)));
typedef float f32x4 __attribute__((ext_vector_type(4)));
typedef unsigned u32x4 __attribute__((ext_vector_type(4)));
typedef unsigned u32x2 __attribute__((ext_vector_type(2)));
typedef unsigned long long u64;

#define DI __device__ __forceinline__
#define MFMA32(a, b, c) __builtin_amdgcn_mfma_f32_32x32x16_bf16((a), (b), (c), 0, 0, 0)

#ifndef MK_PER_PHASE
#define MK_PER_PHASE 0
#endif

constexpr int NT = 32768, DM = 1024, DFF = 2816, SEQ = 4096;
constexpr int LDP_E = 2944, LDP_O = 2048;
constexpr int NPHASES = 45;

constexpr size_t OFF_XB = 0;
constexpr size_t OFF_Y = OFF_XB + (size_t)NT * DM * 2;
constexpr size_t OFF_R = OFF_Y + (size_t)NT * DM * 2;
constexpr size_t SZ_R = (size_t)NT * 3072 * 2;
constexpr size_t OFF_VTO = OFF_R + (size_t)NT * LDP_O * 2;
constexpr size_t OFF_VTS = OFF_R + SZ_R;
constexpr size_t OFF_VTW = OFF_VTS + (size_t)8 * 2 * 64 * 4096 * 2;
constexpr size_t OFF_HC = OFF_VTW + (size_t)8 * 2 * 64 * 4096 * 2;
constexpr size_t OFF_KC = OFF_HC + (size_t)2 * 4096 * 128 * 2;
constexpr size_t OFF_VCT = OFF_KC + (size_t)4096 * 64 * 2;
constexpr size_t OFF_BIAS = OFF_VCT + (size_t)4096 * 64 * 2;
constexpr size_t OFF_W = OFF_BIAS + 4096;
constexpr size_t E_FIN = (size_t)5632 * 1024, E_FOUT = (size_t)1024 * 2816, E_FFN = E_FIN + E_FOUT;
constexpr size_t E_AB = (size_t)3072 * 1024, E_ABO = (size_t)1024 * 1024, E_W1 = (size_t)128 * 2048, E_W2 = (size_t)128 * 128;
constexpr size_t E_EVEN = E_AB + E_ABO + 2 * E_W1 + 2 * E_W2;
constexpr size_t E_QKV = (size_t)3072 * 1024, E_ODD = E_QKV + E_ABO;
constexpr size_t OFF_WFFN = OFF_W;
constexpr size_t OFF_WEVEN = OFF_WFFN + 8 * E_FFN * 2;
constexpr size_t OFF_WODD = OFF_WEVEN + 2 * E_EVEN * 2;
constexpr size_t OFF_BAR = OFF_WODD + 2 * E_ODD * 2;
constexpr size_t WS_END = OFF_BAR + 16384;

struct Params {
  const float* in[20];
  float* X;
  unsigned char* ws;
  int ph_lo, ph_hi;
};

DI bf16_t f2bf(float x) { unsigned u = __float_as_uint(x); u += 0x7fffu + ((u >> 16) & 1u); return (bf16_t)(u >> 16); }
DI float bf2f(bf16_t v) { return __uint_as_float(((unsigned)v) << 16); }
typedef __bf16 hwbf16x2 __attribute__((ext_vector_type(2)));
typedef float f32x2 __attribute__((ext_vector_type(2)));
DI unsigned pack2(float a, float b) { f32x2 v = {a, b}; return __builtin_bit_cast(unsigned, __builtin_convertvector(v, hwbf16x2)); }
DI float bflo(unsigned u) { return __uint_as_float(u << 16); }
DI float bfhi(unsigned u) { return __uint_as_float(u & 0xffff0000u); }
DI float wave_sum(float v) {
#pragma unroll
  for (int o = 1; o < 64; o <<= 1) v += __shfl_xor(v, o);
  return v;
}
DI int otid() { int t = threadIdx.x; asm volatile("" : "+v"(t)); return t; }
DI void half_swap(float x, float& r0, float& r1) {
  const auto r = __builtin_amdgcn_permlane32_swap(__float_as_uint(x), __float_as_uint(x), false, false);
  r0 = __uint_as_float(r[0]); r1 = __uint_as_float(r[1]);
}
DI float half_max(float x) { float a, b; half_swap(x, a, b); return fmaxf(a, b); }
DI float half_sum(float x) { float a, b; half_swap(x, a, b); return a + b; }
DI float half_other(float x, int hh) { float a, b; half_swap(x, a, b); return hh ? a : b; }
DI int crow(int reg, int hh) { return (reg & 3) + 8 * (reg >> 2) + 4 * hh; }
DI float sigmoidf(float x) { return 1.f / (1.f + __expf(-x)); }
DI float gelu_tanh(float x) {
  float u = 0.7978845608028654f * (x + 0.044715f * x * x * x);
  float t = 1.f - 2.f / (1.f + __expf(2.f * u));
  return 0.5f * x * (1.f + t);
}

enum { EPI_SWIGLU = 0, EPI_RESID = 1, EPI_PROJ_EVEN = 2, EPI_PROJ_ODD = 3, EPI_CMP1 = 4, EPI_CMP2 = 5 };

struct GemmArgs {
  const bf16_t* A0; const bf16_t* A1; int lda; int aoff0, aoff1;
  const bf16_t* Bt0; const bf16_t* Bt1;
  int K, NTm, NTn, nmat, gm;
  void* out0; void* out1; void* out2;
  const float* src; float scale;
  const float* bias0; const float* bias1;
};

DI void tile_map(int id, int NTm, int NTn, int& mt, int& nt, int gm = 4) {
  const int x = id & 7, j = id >> 3;
  const int MX = NTm >> 3;
  const int GM = MX < gm ? MX : gm;
  const int per = GM * NTn;
  const int mg = j / per, r = j - mg * per;
  nt = r / GM;
  const int mi = r - nt * GM;
  mt = x * MX + mg * GM + mi;
}

constexpr int LDT = 72;
constexpr int GEMM_LDS = 2 * 2 * 128 * LDT * 2;
constexpr int LDS_BYTES = 2 * GEMM_LDS;

template <int EPI>
DI void gemm_tile(const GemmArgs& g, const int kv, const int mt, const int nt, char* lds, const int kt0 = 0, int kt1 = -1, float* red = nullptr, const int hfid = 0) {
  const int tid = otid() & 255, lane = tid & 63, wave = tid >> 6;
  const int wm = wave >> 1, wn = wave & 1, l32 = lane & 31, hh = lane >> 5;
  bf16_t* As = (bf16_t*)lds;
  bf16_t* Bs = As + 2 * 128 * LDT;
  const int m0 = mt * 128, n0 = nt * 128;
  const int K = g.K, nk = kt1 < 0 ? (K >> 6) : kt1;
  const int lr = tid >> 3, lc = (tid & 7) * 8;
  const bf16_t* Abase = kv ? g.A1 : g.A0;
  const int aoff = kv ? g.aoff1 : g.aoff0;
  const bf16_t* Bbase = (kv ? g.Bt1 : g.Bt0) + (size_t)(n0 + lr) * K + lc;

  auto aaddr = [&](int i, int kt) -> const bf16_t* {
    const int r = m0 + lr + 32 * i;
    if constexpr (EPI == EPI_CMP1) {
      const int bg = r >> 8; int n = r & 255; n = n > 254 ? 254 : n;
      const size_t tok = (size_t)(bg >> 1) * SEQ + 16 * n + kt;
      return Abase + tok * LDP_E + aoff + (bg & 1) * 64 + lc;
    } else {
      return Abase + (size_t)r * g.lda + kt * 64 + lc;
    }
  };

  f32x16 acc[2][2];
#pragma unroll
  for (int i = 0; i < 2; ++i)
#pragma unroll
    for (int j = 0; j < 2; ++j)
#pragma unroll
      for (int e = 0; e < 16; ++e) acc[i][j][e] = 0.f;

  u32x4 ra[4], rb[4];
#pragma unroll
  for (int i = 0; i < 4; ++i) { ra[i] = *(const u32x4*)aaddr(i, kt0); rb[i] = *(const u32x4*)(Bbase + (size_t)(32 * i) * K + kt0 * 64); }
#pragma unroll
  for (int i = 0; i < 4; ++i) { *(u32x4*)&As[(lr + 32 * i) * LDT + lc] = ra[i]; *(u32x4*)&Bs[(lr + 32 * i) * LDT + lc] = rb[i]; }
  __syncthreads();

  for (int kt = kt0; kt < nk; ++kt) {
    const int cur = (kt - kt0) & 1;
    if (kt + 1 < nk) {
#pragma unroll
      for (int i = 0; i < 4; ++i) { ra[i] = *(const u32x4*)aaddr(i, kt + 1); rb[i] = *(const u32x4*)(Bbase + (size_t)(32 * i) * K + (kt + 1) * 64); }
    }
    const bf16_t* as = As + cur * 128 * LDT + (wm * 64 + l32) * LDT + hh * 8;
    const bf16_t* bs = Bs + cur * 128 * LDT + (wn * 64 + l32) * LDT + hh * 8;
#pragma unroll
    for (int ks = 0; ks < 4; ++ks) {
      const bf16x8 a0 = *(const bf16x8*)(as + ks * 16);
      const bf16x8 a1 = *(const bf16x8*)(as + 32 * LDT + ks * 16);
      const bf16x8 b0 = *(const bf16x8*)(bs + ks * 16);
      const bf16x8 b1 = *(const bf16x8*)(bs + 32 * LDT + ks * 16);
      acc[0][0] = MFMA32(a0, b0, acc[0][0]);
      acc[0][1] = MFMA32(a0, b1, acc[0][1]);
      acc[1][0] = MFMA32(a1, b0, acc[1][0]);
      acc[1][1] = MFMA32(a1, b1, acc[1][1]);
    }
    if (kt + 1 < nk) {
      bf16_t* ad = As + (cur ^ 1) * 128 * LDT;
      bf16_t* bd = Bs + (cur ^ 1) * 128 * LDT;
#pragma unroll
      for (int i = 0; i < 4; ++i) { *(u32x4*)&ad[(lr + 32 * i) * LDT + lc] = ra[i]; *(u32x4*)&bd[(lr + 32 * i) * LDT + lc] = rb[i]; }
    }
    __syncthreads();
  }
  if (red) {
    if (hfid == 1) {
#pragma unroll
      for (int i = 0; i < 2; ++i)
#pragma unroll
        for (int j = 0; j < 2; ++j)
#pragma unroll
          for (int e = 0; e < 16; ++e) red[((i * 2 + j) * 16 + e) * 256 + tid] = acc[i][j][e];
    }
    __syncthreads();
    if (hfid == 0) {
#pragma unroll
      for (int i = 0; i < 2; ++i)
#pragma unroll
        for (int j = 0; j < 2; ++j)
#pragma unroll
          for (int e = 0; e < 16; ++e) acc[i][j][e] += red[((i * 2 + j) * 16 + e) * 256 + tid];
    }
    __syncthreads();
    if (hfid == 1) return;
  }

#pragma unroll
  for (int i = 0; i < 2; ++i) {
    const int rbase = m0 + wm * 64 + i * 32 + 4 * hh;
    if constexpr (EPI == EPI_SWIGLU) {
      bf16_t* H = (bf16_t*)g.out0;
      const int hc = ((n0 + wn * 64) >> 1) + l32;
#pragma unroll
      for (int e = 0; e < 16; ++e) {
        const int row = rbase + (e & 3) + 8 * (e >> 2);
        const float gt = acc[i][0][e], up = acc[i][1][e];
        H[(size_t)row * DFF + hc] = f2bf(gt / (1.f + __expf(-gt)) * up);
      }
    } else if constexpr (EPI == EPI_RESID) {
      float* X = (float*)g.out0;
      const float* __restrict__ src = g.src;
      const size_t ibase = (size_t)rbase * DM + n0 + wn * 64 + l32;
#pragma unroll
      for (int j = 0; j < 2; ++j)
#pragma unroll
        for (int e = 0; e < 16; ++e) {
          const float r = __builtin_nontemporal_load(src + ibase + (size_t)((e & 3) + 8 * (e >> 2)) * DM + j * 32);
          acc[i][j][e] = r + g.scale * acc[i][j][e];
        }
#pragma unroll
      for (int j = 0; j < 2; ++j)
#pragma unroll
        for (int e = 0; e < 16; ++e) X[ibase + (size_t)((e & 3) + 8 * (e >> 2)) * DM + j * 32] = acc[i][j][e];
    } else if constexpr (EPI == EPI_PROJ_EVEN) {
      if (n0 == 2432 || n0 == 2688) {
        bf16_t* VT = (bf16_t*)(n0 == 2432 ? g.out1 : g.out2);
#pragma unroll
        for (int j = 0; j < 2; ++j) {
          const int d = j * 32 + l32;
#pragma unroll
          for (int q4 = 0; q4 < 4; ++q4) {
            const int row = rbase + 8 * q4, b = row >> 12, t = row & 4095;
            u32x2 v; v.x = pack2(acc[i][j][4 * q4], acc[i][j][4 * q4 + 1]); v.y = pack2(acc[i][j][4 * q4 + 2], acc[i][j][4 * q4 + 3]);
            *(u32x2*)&VT[((size_t)((b * 2 + wn) * 64 + d)) * SEQ + t] = v;
          }
        }
      } else {
        bf16_t* P = (bf16_t*)g.out0;
#pragma unroll
        for (int j = 0; j < 2; ++j) {
          const int col = n0 + wn * 64 + j * 32 + l32;
          if (col < 2840) {
#pragma unroll
            for (int e = 0; e < 16; ++e) P[(size_t)(rbase + (e & 3) + 8 * (e >> 2)) * LDP_E + col] = f2bf(acc[i][j][e]);
          }
        }
      }
    } else if constexpr (EPI == EPI_PROJ_ODD) {
      if (n0 >= 2048) {
        bf16_t* VT = (bf16_t*)g.out1;
        const int hd = ((n0 - 2048) >> 6) + wn;
#pragma unroll
        for (int j = 0; j < 2; ++j) {
          const int d = j * 32 + l32;
#pragma unroll
          for (int q4 = 0; q4 < 4; ++q4) {
            const int row = rbase + 8 * q4, b = row >> 12, t = row & 4095;
            u32x2 v; v.x = pack2(acc[i][j][4 * q4], acc[i][j][4 * q4 + 1]); v.y = pack2(acc[i][j][4 * q4 + 2], acc[i][j][4 * q4 + 3]);
            *(u32x2*)&VT[((size_t)((b * 16 + hd) * 64 + d)) * SEQ + t] = v;
          }
        }
      } else {
        bf16_t* P = (bf16_t*)g.out0;
#pragma unroll
        for (int j = 0; j < 2; ++j) {
          const int col = n0 + wn * 64 + j * 32 + l32;
#pragma unroll
          for (int e = 0; e < 16; ++e) P[(size_t)(rbase + (e & 3) + 8 * (e >> 2)) * LDP_O + col] = f2bf(acc[i][j][e]);
        }
      }
    } else if constexpr (EPI == EPI_CMP1) {
      bf16_t* H = (bf16_t*)(kv ? g.out1 : g.out0);
      const float* bias = kv ? g.bias1 : g.bias0;
#pragma unroll
      for (int j = 0; j < 2; ++j) {
        const int col = wn * 64 + j * 32 + l32;
        const float bv = bias[col];
#pragma unroll
        for (int e = 0; e < 16; ++e) H[(size_t)(rbase + (e & 3) + 8 * (e >> 2)) * 128 + col] = f2bf(gelu_tanh(acc[i][j][e] + bv));
      }
    } else {
      if (wn == 0) {
#pragma unroll
        for (int j = 0; j < 2; ++j) {
          const int col = j * 32 + l32;
          if (kv == 0) {
            bf16_t* KC = (bf16_t*)g.out0;
#pragma unroll
            for (int e = 0; e < 16; ++e) KC[(size_t)(rbase + (e & 3) + 8 * (e >> 2)) * 64 + col] = f2bf(acc[i][j][e]);
          } else {
            bf16_t* VCT = (bf16_t*)g.out1;
#pragma unroll
            for (int q4 = 0; q4 < 4; ++q4) {
              const int row = rbase + 8 * q4;
              u32x2 v; v.x = pack2(acc[i][j][4 * q4], acc[i][j][4 * q4 + 1]); v.y = pack2(acc[i][j][4 * q4 + 2], acc[i][j][4 * q4 + 3]);
              *(u32x2*)&VCT[((size_t)((row >> 8) * 64 + col)) * 256 + (row & 255)] = v;
            }
          }
        }
      }
    }
  }
}

template <int EPI>
DI void gemm_pair_phase(const GemmArgs& g, char* lds) {
  const int per = g.NTm * g.NTn, total = per * g.nmat;
  const int hf = otid() >> 8;
  for (int id0 = blockIdx.x * 2; id0 < total; id0 += gridDim.x * 2) {
    const int id = id0 + hf;
    const int kv = id / per, idl = id - kv * per;
    int mt, nt; tile_map(idl, g.NTm, g.NTn, mt, nt);
    gemm_tile<EPI>(g, kv, mt, nt, lds + hf * GEMM_LDS);
  }
}

DI void convT(const float* __restrict__ src, int K, int N, int Npad, bf16_t* __restrict__ dst, const float* __restrict__ gain, int mode, char* lds) {
  const int tid512 = otid(), hf0 = tid512 >> 8, tid = tid512 & 255;
  float* tile = (float*)lds + hf0 * (64 * 65);
  const int tk = K >> 6, tn = Npad >> 6, total = tk * tn;
  for (int t0 = blockIdx.x * 2; t0 < total; t0 += gridDim.x * 2) {
    const int t = t0 + hf0;
    const bool act = t < total;
    const int kb = t / tn, nb = t - kb * tn, k0 = kb * 64, n0 = nb * 64;
    __syncthreads();
    if (act) {
      const int n4 = (tid & 15) * 4, n = n0 + n4;
      float sc = 1.f;
      if (mode == 2 && n >= 1536 && n < 2048) sc = 0.125f * 1.4426950408889634f;
      if (mode == 3 && n < 1024) sc = 0.125f * 1.4426950408889634f;
      f32x4 v[4];
#pragma unroll
      for (int i = 0; i < 4; ++i) {
        const int kk = (tid >> 4) + 16 * i;
        v[i] = (n < N) ? *(const f32x4*)&src[(size_t)(k0 + kk) * N + n] : f32x4{0.f, 0.f, 0.f, 0.f};
      }
#pragma unroll
      for (int i = 0; i < 4; ++i) {
        const int kk = (tid >> 4) + 16 * i;
        const float gs = gain ? gain[k0 + kk] * sc : sc;
        tile[kk * 65 + n4 + 0] = v[i].x * gs; tile[kk * 65 + n4 + 1] = v[i].y * gs;
        tile[kk * 65 + n4 + 2] = v[i].z * gs; tile[kk * 65 + n4 + 3] = v[i].w * gs;
      }
    }
    __syncthreads();
    if (act) {
      const int nn = tid >> 2, kc = (tid & 3) * 16, n = n0 + nn;
      int nrow = n;
      if (mode == 1) { const int hf = n >= DFF ? 1 : 0, j = n - hf * DFF; nrow = (j >> 4) * 32 + hf * 16 + (j & 15); }
      u32x4 o0, o1;
      o0.x = pack2(tile[(kc + 0) * 65 + nn], tile[(kc + 1) * 65 + nn]);
      o0.y = pack2(tile[(kc + 2) * 65 + nn], tile[(kc + 3) * 65 + nn]);
      o0.z = pack2(tile[(kc + 4) * 65 + nn], tile[(kc + 5) * 65 + nn]);
      o0.w = pack2(tile[(kc + 6) * 65 + nn], tile[(kc + 7) * 65 + nn]);
      o1.x = pack2(tile[(kc + 8) * 65 + nn], tile[(kc + 9) * 65 + nn]);
      o1.y = pack2(tile[(kc + 10) * 65 + nn], tile[(kc + 11) * 65 + nn]);
      o1.z = pack2(tile[(kc + 12) * 65 + nn], tile[(kc + 13) * 65 + nn]);
      o1.w = pack2(tile[(kc + 14) * 65 + nn], tile[(kc + 15) * 65 + nn]);
      bf16_t* d = dst + (size_t)nrow * K + k0 + kc;
      *(u32x4*)d = o0; *(u32x4*)(d + 8) = o1;
    }
  }
}

DI bf16_t* w_ffn_in(unsigned char* ws, int l, int f) { return (bf16_t*)(ws + OFF_WFFN) + (size_t)(l * 2 + f) * E_FFN; }
DI bf16_t* w_ffn_out(unsigned char* ws, int l, int f) { return w_ffn_in(ws, l, f) + E_FIN; }
DI bf16_t* w_ab(unsigned char* ws, int i) { return (bf16_t*)(ws + OFF_WEVEN) + (size_t)i * E_EVEN; }
DI bf16_t* w_abo(unsigned char* ws, int i) { return w_ab(ws, i) + E_AB; }
DI bf16_t* w_c1(unsigned char* ws, int i, int kv) { return w_abo(ws, i) + E_ABO + (size_t)kv * E_W1; }
DI bf16_t* w_c2(unsigned char* ws, int i, int kv) { return w_abo(ws, i) + E_ABO + 2 * E_W1 + (size_t)kv * E_W2; }
DI bf16_t* w_qkv(unsigned char* ws, int i) { return (bf16_t*)(ws + OFF_WODD) + (size_t)i * E_ODD; }
DI bf16_t* w_sbo(unsigned char* ws, int i) { return w_qkv(ws, i) + E_QKV; }

DI void prep_phase(const Params& p, char* lds) {
  unsigned char* ws = p.ws;
  for (int l = 0; l < 4; ++l) {
    for (int f = 0; f < 2; ++f) {
      const float* win = p.in[f ? 17 : 2] + (size_t)l * 1024 * 5632;
      const float* wout = p.in[f ? 18 : 3] + (size_t)l * 2816 * 1024;
      const float* gn = p.in[f ? 16 : 1] + l * 1024;
      convT(win, 1024, 5632, 5632, w_ffn_in(ws, l, f), gn, 1, lds);
      convT(wout, 2816, 1024, 1024, w_ffn_out(ws, l, f), nullptr, 0, lds);
    }
  }
  for (int i = 0; i < 2; ++i) {
    convT(p.in[5] + (size_t)i * 1024 * 2840, 1024, 2840, 3072, w_ab(ws, i), p.in[4] + (2 * i) * 1024, 2, lds);
    convT(p.in[13] + (size_t)i * 1024 * 1024, 1024, 1024, 1024, w_abo(ws, i), nullptr, 0, lds);
    for (int kv = 0; kv < 2; ++kv) {
      convT(p.in[kv ? 11 : 8] + (size_t)i * 2048 * 128, 2048, 128, 128, w_c1(ws, i, kv), nullptr, 0, lds);
      convT(p.in[kv ? 12 : 9] + (size_t)i * 128 * 64, 128, 64, 128, w_c2(ws, i, kv), nullptr, 0, lds);
    }
    convT(p.in[14] + (size_t)i * 1024 * 3072, 1024, 3072, 3072, w_qkv(ws, i), p.in[4] + (2 * i + 1) * 1024, 3, lds);
    convT(p.in[15] + (size_t)i * 1024 * 1024, 1024, 1024, 1024, w_sbo(ws, i), nullptr, 0, lds);
  }
  const int lane = otid() & 63, gw = blockIdx.x * 8 + (otid() >> 6), nw = gridDim.x * 8;
  float* bias = (float*)(ws + OFF_BIAS);
  for (int o = gw; o < 512; o += nw) {
    const int i = o >> 8, kv = (o >> 7) & 1, j = o & 127;
    const float* pe = p.in[kv ? 10 : 7] + (size_t)i * 2048;
    const float* w1 = p.in[kv ? 11 : 8] + (size_t)i * 2048 * 128;
    float s = 0.f;
    for (int k = lane; k < 2048; k += 64) s += pe[k] * w1[(size_t)k * 128 + j];
    s = wave_sum(s);
    if (lane == 0) bias[o] = s;
  }
}

DI void rownorm_phase(const float* __restrict__ src, bf16_t* __restrict__ dst) {
  const int lane = otid() & 63, gw = blockIdx.x * 8 + (otid() >> 6), nw = gridDim.x * 8;
  for (int row = gw; row < NT; row += nw) {
    const f32x4* xr = (const f32x4*)(src + (size_t)row * DM) + lane;
    f32x4 v[4]; float s = 0.f;
#pragma unroll
    for (int j = 0; j < 4; ++j) { v[j] = xr[64 * j]; s += v[j].x * v[j].x + v[j].y * v[j].y + v[j].z * v[j].z + v[j].w * v[j].w; }
    s = wave_sum(s);
    const float rstd = rsqrtf(s * (1.f / DM) + 1e-6f);
    u32x2* o = (u32x2*)(dst + (size_t)row * DM) + lane;
#pragma unroll
    for (int j = 0; j < 4; ++j) { u32x2 w; w.x = pack2(v[j].x * rstd, v[j].y * rstd); w.y = pack2(v[j].z * rstd, v[j].w * rstd); o[64 * j] = w; }
  }
}
DI void finalnorm_phase(float* __restrict__ X, const float* __restrict__ gain) {
  const int lane = otid() & 63, gw = blockIdx.x * 8 + (otid() >> 6), nw = gridDim.x * 8;
  for (int row = gw; row < NT; row += nw) {
    f32x4* xr = (f32x4*)(X + (size_t)row * DM) + lane;
    const f32x4* gr = (const f32x4*)gain + lane;
    f32x4 v[4]; float s = 0.f;
#pragma unroll
    for (int j = 0; j < 4; ++j) { v[j] = xr[64 * j]; s += v[j].x * v[j].x + v[j].y * v[j].y + v[j].z * v[j].z + v[j].w * v[j].w; }
    s = wave_sum(s);
    const float rstd = rsqrtf(s * (1.f / DM) + 1e-6f);
#pragma unroll
    for (int j = 0; j < 4; ++j) { const f32x4 gg = gr[64 * j]; f32x4 w; w.x = v[j].x * rstd * gg.x; w.y = v[j].y * rstd * gg.y; w.z = v[j].z * rstd * gg.z; w.w = v[j].w * rstd * gg.w; xr[64 * j] = w; }
  }
}

DI void conv_item(const bf16_t* __restrict__ P, const float* __restrict__ cw, bf16_t* __restrict__ Y, int item) {
  const int tid = otid() & 255;
  const int t0 = item * 32 + (tid >> 6) * 8, c0 = (tid & 63) * 8;
  const int tb = t0 & (SEQ - 1);
  float w0[8], w1[8], w2[8], u1[8], u2[8];
#pragma unroll
  for (int e = 0; e < 8; ++e) { w0[e] = cw[c0 + e]; w1[e] = cw[512 + c0 + e]; w2[e] = cw[1024 + c0 + e]; u1[e] = 0.f; u2[e] = 0.f; }
  if (tb >= 1) {
    const bf16_t* r = P + (size_t)(t0 - 1) * LDP_E + c0;
    const u32x4 c = *(const u32x4*)(r + 512), h = *(const u32x4*)(r + 1024);
    u1[0] = bflo(c.x) * bflo(h.x); u1[1] = bfhi(c.x) * bfhi(h.x); u1[2] = bflo(c.y) * bflo(h.y); u1[3] = bfhi(c.y) * bfhi(h.y);
    u1[4] = bflo(c.z) * bflo(h.z); u1[5] = bfhi(c.z) * bfhi(h.z); u1[6] = bflo(c.w) * bflo(h.w); u1[7] = bfhi(c.w) * bfhi(h.w);
  }
  if (tb >= 2) {
    const bf16_t* r = P + (size_t)(t0 - 2) * LDP_E + c0;
    const u32x4 c = *(const u32x4*)(r + 512), h = *(const u32x4*)(r + 1024);
    u2[0] = bflo(c.x) * bflo(h.x); u2[1] = bfhi(c.x) * bfhi(h.x); u2[2] = bflo(c.y) * bflo(h.y); u2[3] = bfhi(c.y) * bfhi(h.y);
    u2[4] = bflo(c.z) * bflo(h.z); u2[5] = bfhi(c.z) * bfhi(h.z); u2[6] = bflo(c.w) * bflo(h.w); u2[7] = bfhi(c.w) * bfhi(h.w);
  }
#pragma unroll
  for (int tt = 0; tt < 8; ++tt) {
    const bf16_t* r = P + (size_t)(t0 + tt) * LDP_E + c0;
    const u32x4 bq = *(const u32x4*)r, c = *(const u32x4*)(r + 512), h = *(const u32x4*)(r + 1024);
    float u0[8], bb[8], y[8];
    u0[0] = bflo(c.x) * bflo(h.x); u0[1] = bfhi(c.x) * bfhi(h.x); u0[2] = bflo(c.y) * bflo(h.y); u0[3] = bfhi(c.y) * bfhi(h.y);
    u0[4] = bflo(c.z) * bflo(h.z); u0[5] = bfhi(c.z) * bfhi(h.z); u0[6] = bflo(c.w) * bflo(h.w); u0[7] = bfhi(c.w) * bfhi(h.w);
    bb[0] = bflo(bq.x); bb[1] = bfhi(bq.x); bb[2] = bflo(bq.y); bb[3] = bfhi(bq.y); bb[4] = bflo(bq.z); bb[5] = bfhi(bq.z); bb[6] = bflo(bq.w); bb[7] = bfhi(bq.w);
#pragma unroll
    for (int e = 0; e < 8; ++e) { y[e] = bb[e] * (w0[e] * u2[e] + w1[e] * u1[e] + w2[e] * u0[e]); u2[e] = u1[e]; u1[e] = u0[e]; }
    u32x4 o; o.x = pack2(y[0], y[1]); o.y = pack2(y[2], y[3]); o.z = pack2(y[4], y[5]); o.w = pack2(y[6], y[7]);
    *(u32x4*)&Y[(size_t)(t0 + tt) * DM + c0] = o;
  }
}

DI void load_tile64(bf16_t* dst, const bf16_t* __restrict__ src, size_t stride) {
  const int c = otid(), row = c >> 3, col = (c & 7) * 8;
  *(u32x4*)&dst[row * LDT + col] = *(const u32x4*)&src[(size_t)row * stride + col];
}
DI u32x4 tile_fetch(const bf16_t* __restrict__ src, size_t stride) {
  const int c = otid(), row = c >> 3, col = (c & 7) * 8;
  return *(const u32x4*)&src[(size_t)row * stride + col];
}
DI void tile_commit(bf16_t* dst, const u32x4& v) {
  const int c = otid(), row = c >> 3, col = (c & 7) * 8;
  *(u32x4*)&dst[row * LDT + col] = v;
}
DI void qk_tile(const bf16_t* Ks, const bf16x8 (&qf)[4], f32x16 (&S)[2], int l32, int hh) {
  bf16x8 kf[2][4];
#pragma unroll
  for (int kt2 = 0; kt2 < 2; ++kt2)
#pragma unroll
    for (int s = 0; s < 4; ++s) kf[kt2][s] = *(const bf16x8*)&Ks[(kt2 * 32 + l32) * LDT + s * 16 + hh * 8];
  __builtin_amdgcn_sched_barrier(0);
#pragma unroll
  for (int kt2 = 0; kt2 < 2; ++kt2)
#pragma unroll
    for (int e = 0; e < 16; ++e) S[kt2][e] = 0.f;
#pragma unroll
  for (int s = 0; s < 4; ++s)
#pragma unroll
    for (int kt2 = 0; kt2 < 2; ++kt2) S[kt2] = MFMA32(kf[kt2][s], qf[s], S[kt2]);
}
DI void pv_tile(const bf16_t* VTs, const f32x16 (&Pm)[2], f32x16 (&O)[2], int l32, int hh) {
#pragma unroll
  for (int kt2 = 0; kt2 < 2; ++kt2) {
    u32x2 lo[2][2], hi[2][2];
#pragma unroll
    for (int t = 0; t < 2; ++t)
#pragma unroll
      for (int dt = 0; dt < 2; ++dt) {
        const bf16_t* vp = &VTs[(dt * 32 + l32) * LDT + kt2 * 32 + 16 * t + 4 * hh];
        lo[t][dt] = *(const u32x2*)vp; hi[t][dt] = *(const u32x2*)(vp + 8);
      }
    __builtin_amdgcn_sched_barrier(0);
#pragma unroll
    for (int t = 0; t < 2; ++t) {
      u32x4 pk;
      pk.x = pack2(Pm[kt2][8 * t + 0], Pm[kt2][8 * t + 1]); pk.y = pack2(Pm[kt2][8 * t + 2], Pm[kt2][8 * t + 3]);
      pk.z = pack2(Pm[kt2][8 * t + 4], Pm[kt2][8 * t + 5]); pk.w = pack2(Pm[kt2][8 * t + 6], Pm[kt2][8 * t + 7]);
      const bf16x8 pf = __builtin_bit_cast(bf16x8, pk);
#pragma unroll
      for (int dt = 0; dt < 2; ++dt) {
        u32x4 vv; vv.x = lo[t][dt].x; vv.y = lo[t][dt].y; vv.z = hi[t][dt].x; vv.w = hi[t][dt].y;
        O[dt] = MFMA32(__builtin_bit_cast(bf16x8, vv), pf, O[dt]);
      }
    }
  }
}
DI float ex2(float x) { return __builtin_amdgcn_exp2f(x); }
template <bool HAS_O>
DI void softmax_finish(f32x16 (&S)[2], float mx, float cbias, float& m, float& l, f32x16 (&O)[2]) {
  mx = half_max(mx);
  const float mn = (mx > m + 8.f) ? mx : m;
  const float alpha = ex2(m - mn);
  m = mn;
  const float c = mn + cbias;
  float sum = 0.f;
#pragma unroll
  for (int kt2 = 0; kt2 < 2; ++kt2)
#pragma unroll
    for (int e = 0; e < 16; ++e) { const float pv = ex2(S[kt2][e] - c); S[kt2][e] = pv; sum += pv; }
  l = l * alpha + sum;
  if constexpr (HAS_O) {
    if (__ballot(alpha != 1.f) != 0ull) {
#pragma unroll
      for (int dt = 0; dt < 2; ++dt)
#pragma unroll
        for (int e = 0; e < 16; ++e) O[dt][e] *= alpha;
    }
  }
}
template <bool HAS_O, class MaskF>
DI void softmax_step(f32x16 (&S)[2], float& m, float& l, f32x16 (&O)[2], int hh, MaskF mask) {
  float mx = -1e30f;
#pragma unroll
  for (int kt2 = 0; kt2 < 2; ++kt2)
#pragma unroll
    for (int e = 0; e < 16; ++e) {
      const float sv = mask(kt2 * 32 + crow(e, hh)) ? S[kt2][e] : -1e30f;
      S[kt2][e] = sv; mx = fmaxf(mx, sv);
    }
  softmax_finish<HAS_O>(S, mx, 0.f, m, l, O);
}
template <bool HAS_O>
DI void softmax_fast(f32x16 (&S)[2], float& m, float& l, f32x16 (&O)[2], bool live) {
  float mx = S[0][0];
#pragma unroll
  for (int kt2 = 0; kt2 < 2; ++kt2)
#pragma unroll
    for (int e = 0; e < 16; ++e) mx = fmaxf(mx, S[kt2][e]);
  softmax_finish<HAS_O>(S, live ? mx : -1e30f, live ? 0.f : 1e30f, m, l, O);
}

constexpr int NSA_SLAB_OFF = 8 * 64 * LDT * 2;
constexpr int NSA_SELM_OFF = NSA_SLAB_OFF + 4 * 64 * 64 * 4;
DI void nsa_item(const bf16_t* __restrict__ P, const bf16_t* __restrict__ KC, const bf16_t* __restrict__ VCT,
                 const bf16_t* __restrict__ VTS, const bf16_t* __restrict__ VTW, bf16_t* __restrict__ Y, int item, char* lds) {
  const int tid = otid(), lane = tid & 63, wave = tid >> 6, l32 = lane & 31, hh = lane >> 5;
  const int xq = (item >> 4) & 15, rnd = item >> 8;
  const int qb = rnd == 0 ? 63 - xq : (rnd == 1 ? xq : (rnd == 2 ? 47 - xq : 16 + xq));
  const int bg = item & 15, b = bg >> 1, g = bg & 1;
  const int hr = wave & 3, qh = wave >> 2;
  const int q0 = qb * 64, cur = qb, pos = q0 + qh * 32 + l32, h = g * 4 + hr;
  const size_t tokbase = (size_t)b * SEQ;
  bf16_t* Ks = (bf16_t*)lds;
  bf16_t* VTs = Ks + 64 * LDT;
  float* slab = (float*)(lds + NSA_SLAB_OFF);
  u64* selm = (u64*)(lds + NSA_SELM_OFF);

  bf16x8 qf[4];
  {
    const bf16_t* qp = P + (tokbase + pos) * LDP_E + 1536 + h * 64 + hh * 8;
#pragma unroll
    for (int s = 0; s < 4; ++s) qf[s] = *(const bf16x8*)(qp + s * 16);
  }
  float g0, g1, g2;
  {
    const bf16_t* gp = P + (tokbase + pos) * LDP_E + 2816 + h * 3;
    g0 = sigmoidf(bf2f(gp[0])); g1 = sigmoidf(bf2f(gp[1])); g2 = sigmoidf(bf2f(gp[2]));
  }
  f32x16 O[2], S[2];
#pragma unroll
  for (int dt = 0; dt < 2; ++dt)
#pragma unroll
    for (int e = 0; e < 16; ++e) O[dt][e] = 0.f;

  const int nct = (((q0 + 32) >> 4) >> 6) + 1;
  const bf16_t* kcb = KC + (size_t)bg * 256 * 64;
  const bf16_t* vcb = VCT + (size_t)bg * 64 * 256;
  float m = -1e29f, l = 0.f;
  u32x4 pfk = tile_fetch(kcb, 64), pfv = pfk;
#pragma unroll 1
  for (int ct = 0; ct < nct; ++ct) {
    __syncthreads();
    tile_commit(Ks, pfk);
    __syncthreads();
    { const int cn = ct + 1 < nct ? ct + 1 : 0;
      pfk = tile_fetch(kcb + (size_t)cn * 64 * 64, 64); pfv = tile_fetch(vcb + cn * 64, 256);
      __builtin_amdgcn_sched_barrier(0); }
    qk_tile(Ks, qf, S, l32, hh);
    softmax_step<false>(S, m, l, O, hh, [&](int kk) { return 16 * (ct * 64 + kk) + 31 <= pos; });
  }
  {
    const float lt = half_sum(l);
    const float inv = lt > 0.f ? 1.f / lt : 0.f;
    float carry3 = 0.f;
    float* myslab = slab + (hr * 64 + qh * 32 + l32) * 64;
#pragma unroll 1
    for (int ct = 0; ct < nct; ++ct) {
      __syncthreads();
      tile_commit(Ks, pfk); tile_commit(VTs, pfv);
      __syncthreads();
      { const int cn = ct + 1 < nct ? ct + 1 : ct;
        pfk = tile_fetch(kcb + (size_t)cn * 64 * 64, 64); pfv = tile_fetch(vcb + cn * 64, 256);
        __builtin_amdgcn_sched_barrier(0); }
      qk_tile(Ks, qf, S, l32, hh);
#pragma unroll
      for (int kt2 = 0; kt2 < 2; ++kt2) {
#pragma unroll
        for (int e = 0; e < 16; ++e) {
          const bool ok = 16 * (ct * 64 + kt2 * 32 + crow(e, hh)) + 31 <= pos;
          S[kt2][e] = ok ? ex2(S[kt2][e] - m) * inv : 0.f;
        }
        float x[4];
#pragma unroll
        for (int j = 0; j < 4; ++j) x[j] = half_other(S[kt2][4 * j + 3], hh);
#pragma unroll
        for (int j = 0; j < 4; ++j) {
          const float prev3 = hh ? x[j] : (j > 0 ? x[j - 1] : carry3);
          const float own = S[kt2][4 * j] + S[kt2][4 * j + 1] + S[kt2][4 * j + 2] + 0.5f * S[kt2][4 * j + 3] + 0.5f * prev3;
          myslab[ct * 16 + kt2 * 8 + 2 * j + hh] = own;
        }
        carry3 = x[3];
#pragma unroll
        for (int e = 0; e < 16; ++e) S[kt2][e] *= g0;
      }
      pv_tile(VTs, S, O, l32, hh);
    }
  }
  __syncthreads();
  {
    const int q = tid >> 3, sub = tid & 7;
    float v[8];
#pragma unroll
    for (int e = 0; e < 8; ++e) {
      const int s = sub * 8 + e;
      v[e] = 0.f;
      if (s <= cur) v[e] = slab[(0 * 64 + q) * 64 + s] + slab[(1 * 64 + q) * 64 + s] + slab[(2 * 64 + q) * 64 + s] + slab[(3 * 64 + q) * 64 + s];
    }
    __syncthreads();
#pragma unroll
    for (int e = 0; e < 8; ++e) { const int s = sub * 8 + e; if (s <= cur) slab[q * 64 + s] = v[e]; }
    __syncthreads();
    unsigned bits = 0;
    if (cur + 1 <= 16) {
#pragma unroll
      for (int e = 0; e < 8; ++e) if (sub * 8 + e <= cur) bits |= 1u << e;
    } else {
      int rank[8];
      u64 key[8];
#pragma unroll
      for (int e = 0; e < 8; ++e) { rank[e] = 0; key[e] = ((u64)__float_as_uint(v[e]) << 32) | (u64)(unsigned)(63 - (sub * 8 + e)); }
#pragma unroll 1
      for (int s2 = 1; s2 <= cur - 2; ++s2) {
        const u64 k2 = ((u64)__float_as_uint(slab[q * 64 + s2]) << 32) | (u64)(unsigned)(63 - s2);
#pragma unroll
        for (int e = 0; e < 8; ++e) rank[e] += (k2 > key[e]) ? 1 : 0;
      }
#pragma unroll
      for (int e = 0; e < 8; ++e) {
        const int s = sub * 8 + e;
        const bool forced = (s == 0) || (s == cur) || (s == cur - 1);
        if (s <= cur && (forced || rank[e] < 13)) bits |= 1u << e;
      }
    }
    unsigned lo = sub < 4 ? (bits << (8 * sub)) : 0u, hi = sub >= 4 ? (bits << (8 * (sub - 4))) : 0u;
#pragma unroll
    for (int o = 1; o < 8; o <<= 1) { lo |= __shfl_xor(lo, o); hi |= __shfl_xor(hi, o); }
    if (sub == 0) selm[q] = ((u64)hi << 32) | lo;
  }
  __syncthreads();
  u64 um = 0;
#pragma unroll 4
  for (int q = 0; q < 64; ++q) um |= selm[q];
  const u64 mym = selm[qh * 32 + l32];
  float* stash = slab + tid;
#pragma unroll
  for (int dt = 0; dt < 2; ++dt)
#pragma unroll
    for (int e = 0; e < 16; ++e) { stash[(dt * 16 + e) * 512] = O[dt][e]; O[dt][e] = 0.f; }

  const bf16_t* ks0 = P + tokbase * LDP_E + 2304 + g * 64;
  const bf16_t* vs0 = VTS + (size_t)bg * 64 * SEQ;
  const bf16_t* kw0 = P + tokbase * LDP_E + 2560 + g * 64;
  const bf16_t* vw0 = VTW + (size_t)bg * 64 * SEQ;
  const int kbs = cur - 8 > 0 ? cur - 8 : 0;
  m = -1e29f; l = 0.f;
  {
    constexpr int TS = 64 * LDT;
    u64 rem = um;
    int sk = 0, si = 0;
    auto advance = [&]() {
      if (sk == 0) { if (rem) { si = __builtin_ctzll(rem); rem &= rem - 1; } else { sk = 1; si = kbs; } }
      else if (sk == 1) { if (si < cur) ++si; else sk = 2; }
    };
    u32x4 pfk1 = pfk, pfv1 = pfv;
    auto fetch1 = [&](int kd, int ix, u32x4& rk, u32x4& rv) {
      const int iv = kd < 2 ? ix : 0;
      const bf16_t* kp = (kd == 0 ? ks0 : kw0) + (size_t)iv * 64 * LDP_E;
      const bf16_t* vp = (kd == 0 ? vs0 : vw0) + iv * 64;
      rk = tile_fetch(kp, LDP_E); rv = tile_fetch(vp, SEQ);
    };
    auto do_tile = [&](int kd, int ix, const bf16_t* kbuf, int knext) {
      qk_tile(kbuf, qf, S, l32, hh);
      if (kd == 0) {
        const bool mine = (mym >> ix) & 1ull;
        if (ix < cur) softmax_fast<true>(S, m, l, O, mine);
        else softmax_step<true>(S, m, l, O, hh, [&](int kk) { return mine && (ix * 64 + kk <= pos); });
      } else {
        if (ix < cur && ix > cur - 8) softmax_fast<true>(S, m, l, O, true);
        else softmax_step<true>(S, m, l, O, hh, [&](int kk) { const int kp = ix * 64 + kk; return kp <= pos && kp > pos - 512; });
      }
      pv_tile(kbuf + TS, S, O, l32, hh);
      if (kd == 0 && knext != 0) {
        const float lt = half_sum(l);
        const float sc = lt > 0.f ? g1 / lt : 0.f;
#pragma unroll
        for (int dt = 0; dt < 2; ++dt)
#pragma unroll
          for (int e = 0; e < 16; ++e) { stash[(dt * 16 + e) * 512] += O[dt][e] * sc; O[dt][e] = 0.f; }
        m = -1e29f; l = 0.f;
      }
    };
    sk = 0; si = __builtin_ctzll(rem); rem &= rem - 1;
    int ka0 = sk, ia0 = si; advance(); int ka1 = sk, ia1 = si;
    fetch1(ka0, ia0, pfk, pfv); fetch1(ka1, ia1, pfk1, pfv1);
    __syncthreads();
    tile_commit(Ks, pfk); tile_commit(Ks + TS, pfv); tile_commit(Ks + 2 * TS, pfk1); tile_commit(Ks + 3 * TS, pfv1);
    advance(); int kb0_ = sk, ib0 = si; advance(); int kb1_ = sk, ib1 = si;
    fetch1(kb0_, ib0, pfk, pfv); fetch1(kb1_, ib1, pfk1, pfv1);
    __syncthreads();
    int par = 0;
#pragma unroll 1
    for (;;) {
      const bf16_t* bcur = Ks + par * (4 * TS);
      bf16_t* bnxt = Ks + (par ^ 1) * (4 * TS);
      tile_commit(bnxt, pfk); tile_commit(bnxt + TS, pfv); tile_commit(bnxt + 2 * TS, pfk1); tile_commit(bnxt + 3 * TS, pfv1);
      advance(); const int kc0 = sk, ic0 = si; advance(); const int kc1 = sk, ic1 = si;
      fetch1(kc0, ic0, pfk, pfv); fetch1(kc1, ic1, pfk1, pfv1);
      __builtin_amdgcn_sched_barrier(0);
      do_tile(ka0, ia0, bcur, ka1);
      if (ka1 < 2) do_tile(ka1, ia1, bcur + 2 * TS, kb0_);
      if (kb0_ == 2) break;
      __syncthreads();
      ka0 = kb0_; ia0 = ib0; ka1 = kb1_; ia1 = ib1; kb0_ = kc0; ib0 = ic0; kb1_ = kc1; ib1 = ic1; par ^= 1;
    }
    const float lt = half_sum(l);
    const float sc = lt > 0.f ? g2 / lt : 0.f;
#pragma unroll
    for (int dt = 0; dt < 2; ++dt)
#pragma unroll
      for (int e = 0; e < 16; ++e) O[dt][e] = stash[(dt * 16 + e) * 512] + O[dt][e] * sc;
  }
  bf16_t* yp = Y + (tokbase + pos) * DM + 512 + h * 64 + 4 * hh;
#pragma unroll
  for (int dt = 0; dt < 2; ++dt)
#pragma unroll
    for (int j = 0; j < 4; ++j) {
      u32x2 v; v.x = pack2(O[dt][4 * j], O[dt][4 * j + 1]); v.y = pack2(O[dt][4 * j + 2], O[dt][4 * j + 3]);
      *(u32x2*)(yp + dt * 32 + 8 * j) = v;
    }
}

DI void sb_item(const bf16_t* __restrict__ P, const bf16_t* __restrict__ VT, bf16_t* __restrict__ Y, int item, char* lds) {
  const int tid = otid(), lane = tid & 63, wave = tid >> 6, l32 = lane & 31, hh = lane >> 5;
  const int qb = item & 15, bh = item >> 4, b = bh >> 4, hd = bh & 15;
  const int q0 = qb * 256 + wave * 32, qpos = q0 + l32;
  const size_t tokbase = (size_t)b * SEQ;
  bf16_t* Ks = (bf16_t*)lds;
  bf16_t* VTs = Ks + 64 * LDT;
  bf16x8 qf[4];
  {
    const bf16_t* qp = P + (tokbase + qpos) * LDP_O + hd * 64 + hh * 8;
#pragma unroll
    for (int s = 0; s < 4; ++s) qf[s] = *(const bf16x8*)(qp + s * 16);
  }
  f32x16 O[2], S[2];
#pragma unroll
  for (int dt = 0; dt < 2; ++dt)
#pragma unroll
    for (int e = 0; e < 16; ++e) O[dt][e] = 0.f;
  float carry = 1.f;
  const bf16_t* kb0 = P + tokbase * LDP_O + 1024 + hd * 64;
  const bf16_t* vb0 = VT + (size_t)bh * 64 * SEQ;
  const int kbs = 4 * qb + 3;
  constexpr int TS = 64 * LDT;
  u32x4 pfk = tile_fetch(kb0 + (size_t)kbs * 64 * LDP_O, LDP_O), pfv = tile_fetch(vb0 + kbs * 64, SEQ);
  u32x4 pfk1 = tile_fetch(kb0 + (size_t)(kbs - 1) * 64 * LDP_O, LDP_O), pfv1 = tile_fetch(vb0 + (kbs - 1) * 64, SEQ);
  __syncthreads();
  tile_commit(Ks, pfk); tile_commit(Ks + TS, pfv); tile_commit(Ks + 2 * TS, pfk1); tile_commit(Ks + 3 * TS, pfv1);
  if (kbs >= 3) {
    pfk = tile_fetch(kb0 + (size_t)(kbs - 2) * 64 * LDP_O, LDP_O); pfv = tile_fetch(vb0 + (kbs - 2) * 64, SEQ);
    pfk1 = tile_fetch(kb0 + (size_t)(kbs - 3) * 64 * LDP_O, LDP_O); pfv1 = tile_fetch(vb0 + (kbs - 3) * 64, SEQ);
  }
  __syncthreads();
  int par = 0, fi = 0;
  volatile int* flags = (volatile int*)(lds + LDS_BYTES + 16);
  auto do_tile = [&](int kb, const bf16_t* kcur) {
    const bool active = (kb * 64 < q0 + 31) && (__ballot(carry > 0.f) != 0ull);
    if (active) {
      qk_tile(kcur, qf, S, l32, hh);
      const bool full = kb * 64 + 63 < q0;
#pragma unroll
      for (int kt2 = 1; kt2 >= 0; --kt2) {
        float st[16];
#pragma unroll
        for (int e = 0; e < 16; ++e) {
          const float ez = ex2(S[kt2][e]);
          const float r = __builtin_amdgcn_rcpf(1.f + ez);
          const bool vis = full || (kb * 64 + kt2 * 32 + crow(e, hh) < qpos);
          st[e] = vis ? r : 1.f;
          S[kt2][e] = vis ? 1.f - r : 0.f;
        }
        float G[4], Go[4];
#pragma unroll
        for (int j = 0; j < 4; ++j) { G[j] = (st[4 * j] * st[4 * j + 1]) * (st[4 * j + 2] * st[4 * j + 3]); Go[j] = half_other(G[j], hh); }
        float T = carry;
#pragma unroll
        for (int j = 3; j >= 0; --j) {
          float run = hh ? T : T * Go[j];
#pragma unroll
          for (int e = 3; e >= 0; --e) {
            const int idx = 4 * j + e;
            S[kt2][idx] *= run;
            run *= st[idx];
          }
          T *= G[j] * Go[j];
        }
        carry = T;
      }
      pv_tile(kcur + TS, S, O, l32, hh);
    }
  };
#pragma unroll 1
  for (int kb = kbs; kb >= 1; kb -= 2) {
    const bf16_t* bcur = Ks + par * (4 * TS);
    bf16_t* bnxt = Ks + (par ^ 1) * (4 * TS);
    tile_commit(bnxt, pfk); tile_commit(bnxt + TS, pfv); tile_commit(bnxt + 2 * TS, pfk1); tile_commit(bnxt + 3 * TS, pfv1);
    {
      const int f0 = kb >= 5 ? kb - 4 : 1, f1 = kb >= 5 ? kb - 5 : 0;
      pfk = tile_fetch(kb0 + (size_t)f0 * 64 * LDP_O, LDP_O); pfv = tile_fetch(vb0 + f0 * 64, SEQ);
      pfk1 = tile_fetch(kb0 + (size_t)f1 * 64 * LDP_O, LDP_O); pfv1 = tile_fetch(vb0 + f1 * 64, SEQ);
      __builtin_amdgcn_sched_barrier(0); }
    par ^= 1;
    do_tile(kb, bcur);
    do_tile(kb - 1, bcur + 2 * TS);
    if (carry > 0.f) flags[fi] = 1;
    __syncthreads();
    const int cont = flags[fi];
    const int fz = fi >= 1 ? fi - 1 : 2;
    if (tid == 0) flags[fz] = 0;
    fi = fi == 2 ? 0 : fi + 1;
    if (!cont) break;
  }
  bf16_t* yp = Y + (tokbase + qpos) * DM + hd * 64 + 4 * hh;
#pragma unroll
  for (int dt = 0; dt < 2; ++dt)
#pragma unroll
    for (int j = 0; j < 4; ++j) {
      u32x2 v; v.x = pack2(O[dt][4 * j], O[dt][4 * j + 1]); v.y = pack2(O[dt][4 * j + 2], O[dt][4 * j + 3]);
      *(u32x2*)(yp + dt * 32 + 8 * j) = v;
    }
}


#define XB_TMO      128
#define XB_XCNT(j)  (256  + 64 * (j))
#define XB_XSUB(j)  (1280 + 64 * (j))
#define XB_XGEN(j)  (2304 + 64 * (j))
#define XB_TOP      3328
#define XB_TOPGEN   3392
#define XCD_BAR_WORDS 3456
#define XB_SPIN_CAP (1u << 22)
#define LAS __attribute__((address_space(3)))
DI unsigned xb_ld(unsigned* p) { return __hip_atomic_load(p, __ATOMIC_RELAXED, __HIP_MEMORY_SCOPE_AGENT); }
DI unsigned xb_add(unsigned* p, unsigned v) { return __hip_atomic_fetch_add(p, v, __ATOMIC_RELAXED, __HIP_MEMORY_SCOPE_AGENT); }
DI unsigned xb_xcc_id() { return (unsigned)__builtin_amdgcn_s_getreg((3 << 11) | 20) & 0xFu; }
#define XB_SPIN(cond, bar) do { unsigned _sp = 0; while (cond) { __builtin_amdgcn_s_sleep(1); \
    if ((++_sp & 255u) == 0u) { if (xb_ld(&(bar)[XB_TMO])) break; if (_sp > XB_SPIN_CAP) { atomicAdd(&(bar)[XB_TMO], 1u); break; } } } } while (0)
struct XcdBarrier { unsigned* bar; unsigned x; volatile LAS unsigned* st; };
DI XcdBarrier xcd_barrier_post(unsigned* bar, volatile LAS unsigned* st) {
  XcdBarrier b; b.bar = bar; b.x = xb_xcc_id(); b.st = st;
  if (threadIdx.x == 0) (void)xb_add(&bar[XB_XCNT(b.x)], 1u);
  return b;
}
DI void xcd_barrier_complete(unsigned* bar, unsigned x, unsigned& nloc, unsigned& nx) {
  const unsigned G = gridDim.x * gridDim.y * gridDim.z;
  unsigned sum, cnt, mine, sp = 0u;
  for (;;) {
    sum = 0u; cnt = 0u; mine = 0u;
#pragma unroll
    for (unsigned j = 0; j < 16; ++j) { const unsigned c = xb_ld(&bar[XB_XCNT(j)]); sum += c; cnt += (c > 0u) ? 1u : 0u; mine = (j == x) ? c : mine; }
    if (sum == G) break;
    __builtin_amdgcn_s_sleep(1);
    if ((++sp & 255u) == 0u) { if (xb_ld(&bar[XB_TMO])) break; if (sp > XB_SPIN_CAP) { atomicAdd(&bar[XB_TMO], 1u); break; } }
  }
  nloc = mine > 0u ? mine : 1u; nx = cnt > 0u ? cnt : 1u;
}
DI void xcd_barrier(const XcdBarrier& b) {
  asm volatile("s_waitcnt vmcnt(0)" ::: "memory");
  __syncthreads();
  if (threadIdx.x == 0) {
    unsigned* bar = b.bar;
    __builtin_amdgcn_s_waitcnt(0);
    unsigned nloc = b.st[0], nx = b.st[1];
    if (nloc == 0u) { xcd_barrier_complete(bar, b.x, nloc, nx); b.st[0] = nloc; b.st[1] = nx; }
    const unsigned old = xb_add(&bar[XB_XSUB(b.x)], 1u);
    const unsigned gen = old / nloc;
    if (old + 1u == (gen + 1u) * nloc) {
      __builtin_amdgcn_fence(__ATOMIC_RELEASE, "agent");
      asm volatile("s_waitcnt vmcnt(0)" ::: "memory");
      const unsigned og = xb_add(&bar[XB_TOP], 1u);
      const unsigned tg = og / nx;
      if (og + 1u == (tg + 1u) * nx) xb_add(&bar[XB_TOPGEN], 1u);
      else XB_SPIN(xb_ld(&bar[XB_TOPGEN]) == tg, bar);
      __builtin_amdgcn_fence(__ATOMIC_ACQUIRE, "agent");
      xb_add(&bar[XB_XGEN(b.x)], 1u);
      asm volatile("s_waitcnt vmcnt(0)" ::: "memory");
    } else {
      XB_SPIN(xb_ld(&bar[XB_XGEN(b.x)]) == gen, bar);
      __builtin_amdgcn_fence(__ATOMIC_ACQUIRE, "agent");
      asm volatile("s_waitcnt vmcnt(0)" ::: "memory");
    }
  }
  __syncthreads();
}


namespace g8 {
constexpr int BK = 64, HALF = 128, HT = HALF * BK;
DI int lds_byte(int r, int c) { const int st = (r >> 4) * 2 + (c >> 5), rr = r & 15, cc = c & 31, ob = rr * 64 + cc * 2; return st * 1024 + (ob ^ (((ob >> 9) & 1) << 5)); }
DI void stage_rc(int b, int& R, int& C) { const int st = b / 1024, sb = b % 1024, swz = sb ^ (((sb >> 9) & 1) << 5); R = (st >> 1) * 16 + swz / 64; C = (st & 1) * 32 + (swz % 64) / 2; }
}

DI void gemm8_resid_epilogue(const GemmArgs& g, f32x4 (&acc)[2][2][4][2], const int brow, const int bcol, const int wr, const int wc, const int fr, const int fq) {
  float* X = (float*)g.out0;
  const float* src = g.src;
  const float sc = g.scale;
  auto base = [&](int ai, int bj) -> size_t { return (size_t)(brow + ai * 128 + wr * 64 + fr) * DM + bcol + bj * 128 + wc * 32 + fq * 4; };
  f32x4 ra[4][2], rb[4][2];
  auto ld = [&](f32x4 (&r)[4][2], size_t ib) {
#pragma unroll
    for (int m = 0; m < 4; ++m)
#pragma unroll
      for (int n = 0; n < 2; ++n) r[m][n] = *(const f32x4*)(src + ib + (size_t)(m * 16) * DM + n * 16);
  };
  auto st = [&](const f32x4 (&r)[4][2], const f32x4 (&a)[4][2], size_t ib) {
#pragma unroll
    for (int m = 0; m < 4; ++m)
#pragma unroll
      for (int n = 0; n < 2; ++n) {
        f32x4 o;
        o.x = r[m][n].x + sc * a[m][n][0]; o.y = r[m][n].y + sc * a[m][n][1];
        o.z = r[m][n].z + sc * a[m][n][2]; o.w = r[m][n].w + sc * a[m][n][3];
        *(f32x4*)(X + ib + (size_t)(m * 16) * DM + n * 16) = o;
      }
  };
  const size_t b00 = base(0, 0), b01 = base(0, 1), b10 = base(1, 0), b11 = base(1, 1);
  ld(ra, b00); ld(rb, b01);
  st(ra, acc[0][0], b00); ld(ra, b10);
  st(rb, acc[0][1], b01); ld(rb, b11);
  st(ra, acc[1][0], b10);
  st(rb, acc[1][1], b11);
}

template <int EPI>
DI void gemm8_epilogue(const GemmArgs& g, f32x4 (&acc)[2][2][4][2], const int brow, const int bcol, const int wr, const int wc, const int fr, const int fq) {
#pragma unroll
  for (int ai = 0; ai < 2; ++ai) {
#pragma unroll
    for (int bj = 0; bj < 2; ++bj) {
      const int cb = bcol + bj * 128 + wc * 32;
      const int r0 = brow + ai * 128 + wr * 64 + fr;
      if constexpr (EPI == EPI_SWIGLU) {
        bf16_t* H = (bf16_t*)g.out0;
        const int hc = (cb >> 1) + fq * 4;
#pragma unroll
        for (int m = 0; m < 4; ++m) {
          float v[4];
#pragma unroll
          for (int j = 0; j < 4; ++j) { const float gt = acc[ai][bj][m][0][j], up = acc[ai][bj][m][1][j]; v[j] = gt * up * __builtin_amdgcn_rcpf(1.f + __expf(-gt)); }
          u32x2 o; o.x = pack2(v[0], v[1]); o.y = pack2(v[2], v[3]);
          *(u32x2*)&H[(size_t)(r0 + m * 16) * DFF + hc] = o;
        }
      } else if constexpr (EPI == EPI_RESID) {
        float* X = (float*)g.out0;
        const float* __restrict__ src = g.src;
        const size_t ibase = (size_t)r0 * DM + cb + fq * 4;
        f32x4 rr[4][2];
#pragma unroll
        for (int m = 0; m < 4; ++m)
#pragma unroll
          for (int n = 0; n < 2; ++n) rr[m][n] = *(const f32x4*)(src + ibase + (size_t)(m * 16) * DM + n * 16);
#pragma unroll
        for (int m = 0; m < 4; ++m)
#pragma unroll
          for (int n = 0; n < 2; ++n) {
            f32x4 o;
            o.x = rr[m][n].x + g.scale * acc[ai][bj][m][n][0]; o.y = rr[m][n].y + g.scale * acc[ai][bj][m][n][1];
            o.z = rr[m][n].z + g.scale * acc[ai][bj][m][n][2]; o.w = rr[m][n].w + g.scale * acc[ai][bj][m][n][3];
            *(f32x4*)(X + ibase + (size_t)(m * 16) * DM + n * 16) = o;
          }
      } else if constexpr (EPI == EPI_PROJ_EVEN) {
        if ((bcol == 2304 || bcol == 2560) && bj == 1) {
          bf16_t* VT = (bf16_t*)(bcol == 2304 ? g.out1 : g.out2);
#pragma unroll
          for (int m = 0; m < 4; ++m) {
            const int row = r0 + m * 16, b = row >> 12, t = row & 4095;
#pragma unroll
            for (int n = 0; n < 2; ++n)
#pragma unroll
              for (int j = 0; j < 4; ++j) {
                const int d = wc * 32 + n * 16 + fq * 4 + j;
                VT[((size_t)((b * 2 + (d >> 6)) * 64 + (d & 63))) * SEQ + t] = f2bf(acc[ai][bj][m][n][j]);
              }
          }
        } else {
          bf16_t* P = (bf16_t*)g.out0;
#pragma unroll
          for (int n = 0; n < 2; ++n) {
            const int col = cb + n * 16 + fq * 4;
            if (col < 2840) {
#pragma unroll
              for (int m = 0; m < 4; ++m) {
                u32x2 o; o.x = pack2(acc[ai][bj][m][n][0], acc[ai][bj][m][n][1]); o.y = pack2(acc[ai][bj][m][n][2], acc[ai][bj][m][n][3]);
                *(u32x2*)&P[(size_t)(r0 + m * 16) * LDP_E + col] = o;
              }
            }
          }
        }
      } else {
        if (bcol >= 2048) {
          bf16_t* VT = (bf16_t*)g.out1;
#pragma unroll
          for (int m = 0; m < 4; ++m) {
            const int row = r0 + m * 16, b = row >> 12, t = row & 4095;
#pragma unroll
            for (int n = 0; n < 2; ++n)
#pragma unroll
              for (int j = 0; j < 4; ++j) {
                const int c = cb - 2048 + n * 16 + fq * 4 + j;
                VT[((size_t)((b * 16 + (c >> 6)) * 64 + (c & 63))) * SEQ + t] = f2bf(acc[ai][bj][m][n][j]);
              }
          }
        } else {
          bf16_t* P = (bf16_t*)g.out0;
#pragma unroll
          for (int n = 0; n < 2; ++n) {
            const int col = cb + n * 16 + fq * 4;
#pragma unroll
            for (int m = 0; m < 4; ++m) {
              u32x2 o; o.x = pack2(acc[ai][bj][m][n][0], acc[ai][bj][m][n][1]); o.y = pack2(acc[ai][bj][m][n][2], acc[ai][bj][m][n][3]);
              *(u32x2*)&P[(size_t)(r0 + m * 16) * LDP_O + col] = o;
            }
          }
        }
      }
    }
  }
}

template <int EPI, bool ALIGN_EPI = true, bool SP2 = true>
DI void gemm8_phase(const GemmArgs& g, char* lds_) {
  using namespace g8;
  LAS unsigned char* lds = (LAS unsigned char*)lds_;
  const int tid = otid();
  const int wid = __builtin_amdgcn_readfirstlane(tid >> 6), lane = tid & 63, wr = wid >> 2, wc = wid & 3, fr = lane & 15, fq = lane >> 4;
  constexpr bool TRANSPOSED = true;
  constexpr int EPI_VM = 0;
  const int K = g.K, nt = K / BK;
  const int total = g.NTm * g.NTn, G = gridDim.x;
  if ((int)blockIdx.x >= total) return;
  unsigned voff[2];
#pragma unroll
  for (int i = 0; i < 2; ++i) { int R, C; stage_rc(tid * 16 + i * 8192, R, C); voff[i] = (unsigned)(R * K + C) * 2u; }
  const size_t kstep = (size_t)(BK * 2);
  const size_t hstep = (size_t)HALF * K * 2;
  const size_t tstep = 2 * hstep;
  const unsigned ldsw = (unsigned)wid * 1024u;
  const int aoff = lds_byte(wr * 64 + fr, fq * 8), boff = lds_byte(wc * 32 + fr, fq * 8);
  constexpr int HTB = HT * 2;
#define PG8_SA(b, h) (((b) * 2 + (h)) * HTB)
#define PG8_SB(b, h) ((4 + (b) * 2 + (h)) * HTB)
#define PG8_STAGE(bufoff, gbase) do { _Pragma("unroll") for (int _i = 0; _i < 2; ++_i) \
    __builtin_amdgcn_global_load_lds((const unsigned*)((const char*)(gbase) + voff[_i]), (LAS unsigned*)(lds + (bufoff) + ldsw + _i * 8192), 16, 0, 0); } while (0)
#define PG8_LDA(dst, b, h) do { _Pragma("unroll") for (int m = 0; m < 4; ++m) _Pragma("unroll") for (int k = 0; k < 2; ++k) dst[m][k] = *(const LAS bf16x8*)(lds + PG8_SA(b, h) + aoff + m * 2048 + k * 1024); } while (0)
#define PG8_LDB(dst, b, h) do { _Pragma("unroll") for (int n = 0; n < 2; ++n) _Pragma("unroll") for (int k = 0; k < 2; ++k) dst[n][k] = *(const LAS bf16x8*)(lds + PG8_SB(b, h) + boff + n * 2048 + k * 1024); } while (0)
#define PG8_MMA(ai, bj, At_, Bt_) do { __builtin_amdgcn_s_setprio(1); _Pragma("unroll") for (int m = 0; m < 4; ++m) _Pragma("unroll") for (int n = 0; n < 2; ++n) _Pragma("unroll") for (int k = 0; k < 2; ++k) \
    acc[ai][bj][m][n] = TRANSPOSED ? __builtin_amdgcn_mfma_f32_16x16x32_bf16(Bt_[n][k], At_[m][k], acc[ai][bj][m][n], 0, 0, 0) \
                                   : __builtin_amdgcn_mfma_f32_16x16x32_bf16(At_[m][k], Bt_[n][k], acc[ai][bj][m][n], 0, 0, 0); __builtin_amdgcn_s_setprio(0); } while (0)
#define PG8_WAIT_V(n) asm volatile("s_waitcnt vmcnt(" #n ")" ::: "memory")
#define PG8_WAIT_L(n) asm volatile("s_waitcnt lgkmcnt(" #n ")" ::: "memory")
#define PG8_BAR __builtin_amdgcn_s_barrier()
#define PG8_SCHED __builtin_amdgcn_sched_barrier(0)
  int ui = 0, cpm, cpn, npm = 0, npn = 0;
  tile_map(blockIdx.x, g.NTm, g.NTn, cpm, cpn, g.gm);
  f32x4 acc[2][2][4][2];
#pragma unroll
  for (int a = 0; a < 2; ++a)
#pragma unroll
    for (int b = 0; b < 2; ++b)
#pragma unroll
      for (int m = 0; m < 4; ++m)
#pragma unroll
        for (int n = 0; n < 2; ++n) acc[a][b][m][n] = f32x4{0.f, 0.f, 0.f, 0.f};
  bf16x8 At[4][2], B0[2][2], B1[2][2];
  const char* cA = (const char*)g.A0 + (size_t)cpm * tstep;
  const char* cB = (const char*)g.Bt0 + (size_t)cpn * tstep;
  PG8_WAIT_V(0);
  __syncthreads();
  if constexpr (SP2) {
    PG8_STAGE(PG8_SB(0, 0), cB); PG8_STAGE(PG8_SB(0, 1), cB + hstep); PG8_STAGE(PG8_SA(0, 0), cA); PG8_STAGE(PG8_SA(0, 1), cA + hstep);
    if (wr == 1) PG8_BAR;
    PG8_WAIT_V(2); PG8_BAR;
    PG8_STAGE(PG8_SB(1, 0), cB + kstep); PG8_STAGE(PG8_SA(1, 0), cA + kstep); PG8_STAGE(PG8_SB(1, 1), cB + hstep + kstep);
    PG8_WAIT_V(6); PG8_BAR;
  } else {
    PG8_STAGE(PG8_SB(0, 0), cB); PG8_STAGE(PG8_SA(0, 0), cA); PG8_STAGE(PG8_SB(0, 1), cB + hstep); PG8_STAGE(PG8_SA(0, 1), cA + hstep);
    if (wr == 1) PG8_BAR;
    PG8_WAIT_V(4); PG8_BAR;
    PG8_STAGE(PG8_SB(1, 0), cB + kstep); PG8_STAGE(PG8_SA(1, 0), cA + kstep); PG8_STAGE(PG8_SB(1, 1), cB + hstep + kstep);
    PG8_WAIT_V(6); PG8_BAR;
  }
  for (;;) {
    const int nid = (int)blockIdx.x + (ui + 1) * G;
    const bool has_next = nid < total;
    if (has_next) tile_map(nid, g.NTm, g.NTn, npm, npn, g.gm);
    const char* nA = has_next ? (const char*)g.A0 + (size_t)npm * tstep : cA;
    const char* nB = has_next ? (const char*)g.Bt0 + (size_t)npn * tstep : cB;
#pragma unroll 1
    for (int t = 0; t < nt; t += 2) {
      const bool last = (t == nt - 2);
      const char* a1 = cA + (size_t)(t + 1) * kstep;
      const char* a2 = last ? nA : cA + (size_t)(t + 2) * kstep;
      const char* b2 = last ? nB : cB + (size_t)(t + 2) * kstep;
      const char* a3 = a2 + kstep; const char* b3 = b2 + kstep;
      if constexpr (SP2) {
        const bool relax = EPI_VM > 0 && t == 0 && ui > 0;
        PG8_LDB(B0, 0, 0); PG8_LDB(B1, 0, 1); PG8_SCHED; PG8_LDA(At, 0, 0); PG8_STAGE(PG8_SA(1, 1), a1 + hstep);
        if (relax) PG8_WAIT_V(24); else PG8_WAIT_V(8);
        PG8_WAIT_L(0); PG8_BAR; PG8_MMA(0, 0, At, B0); PG8_MMA(0, 1, At, B1); PG8_BAR; PG8_SCHED;
        PG8_LDA(At, 0, 1); PG8_STAGE(PG8_SB(0, 0), b2); PG8_STAGE(PG8_SB(0, 1), b2 + hstep); PG8_STAGE(PG8_SA(0, 0), a2);
        if (relax) PG8_WAIT_V(24); else PG8_WAIT_V(8);
        PG8_WAIT_L(0); PG8_BAR; PG8_MMA(1, 0, At, B0); PG8_MMA(1, 1, At, B1); PG8_BAR; PG8_SCHED;
        PG8_LDB(B0, 1, 0); PG8_LDB(B1, 1, 1); PG8_SCHED; PG8_LDA(At, 1, 0); PG8_STAGE(PG8_SA(0, 1), a2 + hstep);
        PG8_WAIT_V(8); PG8_WAIT_L(0); PG8_BAR; PG8_MMA(0, 0, At, B0); PG8_MMA(0, 1, At, B1); PG8_BAR; PG8_SCHED;
        PG8_LDA(At, 1, 1); PG8_STAGE(PG8_SB(1, 0), b3); PG8_STAGE(PG8_SB(1, 1), b3 + hstep); PG8_STAGE(PG8_SA(1, 0), a3);
        PG8_WAIT_V(8); PG8_WAIT_L(0); PG8_BAR; PG8_MMA(1, 0, At, B0); PG8_MMA(1, 1, At, B1); PG8_BAR; PG8_SCHED;
      } else {
        PG8_LDB(B0, 0, 0); PG8_SCHED; PG8_LDA(At, 0, 0); PG8_STAGE(PG8_SA(1, 1), a1 + hstep);
        PG8_WAIT_L(8); PG8_BAR; PG8_WAIT_L(0); PG8_MMA(0, 0, At, B0); PG8_BAR; PG8_SCHED;
        PG8_LDB(B1, 0, 1); PG8_STAGE(PG8_SB(0, 0), b2);
        PG8_BAR; PG8_WAIT_L(0); PG8_MMA(0, 1, At, B1); PG8_BAR;
        PG8_LDA(At, 0, 1); PG8_STAGE(PG8_SA(0, 0), a2);
        PG8_BAR; PG8_WAIT_L(0); PG8_MMA(1, 0, At, B0); PG8_BAR; PG8_SCHED;
        PG8_STAGE(PG8_SB(0, 1), b2 + hstep);
        PG8_WAIT_V(6); PG8_BAR; PG8_MMA(1, 1, At, B1); PG8_BAR;
        PG8_LDB(B0, 1, 0); PG8_SCHED; PG8_LDA(At, 1, 0); PG8_STAGE(PG8_SA(0, 1), a2 + hstep);
        PG8_WAIT_L(8); PG8_BAR; PG8_WAIT_L(0); PG8_MMA(0, 0, At, B0); PG8_BAR; PG8_SCHED;
        PG8_LDB(B1, 1, 1); PG8_STAGE(PG8_SB(1, 0), b3);
        PG8_BAR; PG8_WAIT_L(0); PG8_MMA(0, 1, At, B1); PG8_BAR;
        PG8_LDA(At, 1, 1); PG8_STAGE(PG8_SA(1, 0), a3);
        PG8_BAR; PG8_WAIT_L(0); PG8_MMA(1, 0, At, B0); PG8_BAR; PG8_SCHED;
        PG8_STAGE(PG8_SB(1, 1), b3 + hstep);
        PG8_WAIT_V(6); PG8_BAR; PG8_MMA(1, 1, At, B1); PG8_BAR;
      }
    }
    if constexpr (ALIGN_EPI) { if (wr == 0) PG8_BAR; }
    if constexpr (EPI == EPI_RESID) gemm8_resid_epilogue(g, acc, cpm * 256, cpn * 256, wr, wc, fr, fq);
    else gemm8_epilogue<EPI>(g, acc, cpm * 256, cpn * 256, wr, wc, fr, fq);
    if (!has_next) break;
#pragma unroll
    for (int a = 0; a < 2; ++a)
#pragma unroll
      for (int b = 0; b < 2; ++b)
#pragma unroll
        for (int m = 0; m < 4; ++m)
#pragma unroll
          for (int n = 0; n < 2; ++n) acc[a][b][m][n] = f32x4{0.f, 0.f, 0.f, 0.f};
    cpm = npm; cpn = npn; cA = nA; cB = nB; ++ui;
    if constexpr (ALIGN_EPI) { if (wr == 1) PG8_BAR; }
  }
  PG8_WAIT_V(0);
  if constexpr (!ALIGN_EPI) { if (wr == 0) PG8_BAR; }
  PG8_BAR;
#undef PG8_SA
#undef PG8_SB
#undef PG8_STAGE
#undef PG8_LDA
#undef PG8_LDB
#undef PG8_MMA
#undef PG8_WAIT_V
#undef PG8_WAIT_L
#undef PG8_BAR
#undef PG8_SCHED
}

#define PH_BEGIN if (ph >= p.ph_lo && ph < p.ph_hi) {
#define PH_END   if (ph + 1 < p.ph_hi) { if (p.ph_hi < 0) grid.sync(); else xcd_barrier(xb); } } ++ph;

__global__ void __launch_bounds__(512, 2) fwd_megakernel(Params p) {
  __shared__ __attribute__((aligned(16))) char lds[LDS_BYTES + 64];
  cg::grid_group grid = cg::this_grid();
  unsigned char* ws = p.ws;
  if (threadIdx.x < 16) ((unsigned*)(lds + LDS_BYTES))[threadIdx.x] = 0u;
  __syncthreads();
  XcdBarrier xb = xcd_barrier_post((unsigned*)(ws + OFF_BAR), (volatile LAS unsigned*)(LAS char*)(lds + LDS_BYTES));
  bf16_t* XB = (bf16_t*)(ws + OFF_XB);
  bf16_t* Yb = (bf16_t*)(ws + OFF_Y);
  bf16_t* R = (bf16_t*)(ws + OFF_R);
  float* X = p.X;
  int ph = 0;

  PH_BEGIN
    prep_phase(p, lds);
    rownorm_phase(p.in[0], XB);
  PH_END

#pragma unroll 1
  for (int step = 0; step < 12; ++step) {
    const int l = step / 3, s = step - 3 * l;
    GemmArgs ra{};
    ra.NTm = 128; ra.NTn = 4; ra.nmat = 1; ra.gm = 4; ra.out0 = X; ra.src = (step == 0) ? p.in[0] : X;
    if (s != 1) {
      const int f = s >> 1;
      PH_BEGIN
        GemmArgs ga{};
        ga.A0 = XB; ga.lda = DM; ga.Bt0 = w_ffn_in(ws, l, f); ga.K = DM; ga.NTm = 128; ga.NTn = 22; ga.nmat = 1; ga.gm = 4; ga.out0 = R;
        gemm8_phase<EPI_SWIGLU>(ga, lds);
      PH_END
      ra.A0 = R; ra.lda = DFF; ra.K = DFF; ra.Bt0 = w_ffn_out(ws, l, f); ra.scale = 0.5f; ra.gm = 2;
    } else if ((l & 1) == 0) {
      const int i = l >> 1;
      bf16_t* VTS = (bf16_t*)(ws + OFF_VTS);
      bf16_t* VTW = (bf16_t*)(ws + OFF_VTW);
      bf16_t* HC = (bf16_t*)(ws + OFF_HC);
      bf16_t* KC = (bf16_t*)(ws + OFF_KC);
      bf16_t* VCT = (bf16_t*)(ws + OFF_VCT);
      PH_BEGIN
        GemmArgs ga{};
        ga.A0 = XB; ga.lda = DM; ga.Bt0 = w_ab(ws, i); ga.K = DM; ga.NTm = 128; ga.NTn = 12; ga.nmat = 1; ga.gm = 4;
        ga.out0 = R; ga.out1 = VTS; ga.out2 = VTW;
        gemm8_phase<EPI_PROJ_EVEN>(ga, lds);
      PH_END
      PH_BEGIN
        GemmArgs ga{};
        ga.A0 = R; ga.A1 = R; ga.aoff0 = 2048; ga.aoff1 = 2176; ga.Bt0 = w_c1(ws, i, 0); ga.Bt1 = w_c1(ws, i, 1);
        ga.K = 2048; ga.NTm = 32; ga.NTn = 1; ga.nmat = 2; ga.out0 = HC; ga.out1 = HC + 4096 * 128;
        ga.bias0 = (const float*)(ws + OFF_BIAS) + (i * 2 + 0) * 128; ga.bias1 = (const float*)(ws + OFF_BIAS) + (i * 2 + 1) * 128;
        const float* cw = p.in[6] + (size_t)i * 3 * 512;
        const int hf = otid() >> 8;
        for (int id = blockIdx.x; id < 64 + 512; id += gridDim.x) {
          if (id < 64) {
            const int kv = id >> 5; int mt, nt; tile_map(id & 31, 32, 1, mt, nt);
            gemm_tile<EPI_CMP1>(ga, kv, mt, nt, lds + hf * GEMM_LDS, hf * 16, hf * 16 + 16, (float*)(lds + GEMM_LDS), hf);
          } else {
            conv_item(R, cw, Yb, (id - 64) * 2 + hf);
          }
        }
      PH_END
      PH_BEGIN
        GemmArgs ga{};
        ga.A0 = HC; ga.A1 = HC + 4096 * 128; ga.lda = 128; ga.Bt0 = w_c2(ws, i, 0); ga.Bt1 = w_c2(ws, i, 1);
        ga.K = 128; ga.NTm = 32; ga.NTn = 1; ga.nmat = 2; ga.out0 = KC; ga.out1 = VCT;
        gemm_pair_phase<EPI_CMP2>(ga, lds);
      PH_END
      PH_BEGIN
        for (int it = blockIdx.x; it < 1024; it += gridDim.x) nsa_item(R, KC, VCT, VTS, VTW, Yb, it, lds);
      PH_END
      ra.A0 = Yb; ra.lda = DM; ra.K = DM; ra.Bt0 = w_abo(ws, i); ra.scale = 1.f;
    } else {
      const int i = l >> 1;
      bf16_t* VTO = (bf16_t*)(ws + OFF_VTO);
      PH_BEGIN
        GemmArgs ga{};
        ga.A0 = XB; ga.lda = DM; ga.Bt0 = w_qkv(ws, i); ga.K = DM; ga.NTm = 128; ga.NTn = 12; ga.nmat = 1; ga.gm = 4;
        ga.out0 = R; ga.out1 = VTO;
        gemm8_phase<EPI_PROJ_ODD>(ga, lds);
      PH_END
      PH_BEGIN
        for (int it = blockIdx.x; it < 2048; it += gridDim.x) sb_item(R, VTO, Yb, it, lds);
      PH_END
      ra.A0 = Yb; ra.lda = DM; ra.K = DM; ra.Bt0 = w_sbo(ws, i); ra.scale = 1.f;
    }
    PH_BEGIN
      gemm8_phase<EPI_RESID, false>(ra, lds);
    PH_END
    PH_BEGIN
      if (step < 11) rownorm_phase(X, XB);
      else finalnorm_phase(X, p.in[19]);
    PH_END
  }
}

extern "C" void kernel_launch(void* const* d_in, const int* in_sizes, int n_in, void* d_out, int out_size, void* d_ws, size_t ws_size,
                              hipStream_t stream) {
  static int grid_blocks = 0;
  if (!grid_blocks) {
    int dev = 0, cus = 0, per_cu = 0;
    (void)hipGetDevice(&dev);
    (void)hipDeviceGetAttribute(&cus, hipDeviceAttributeMultiprocessorCount, dev);
    (void)hipOccupancyMaxActiveBlocksPerMultiprocessor(&per_cu, fwd_megakernel, 512, 0);
    if (per_cu != 1) fprintf(stderr, "kernel_launch: occupancy query says %d blocks/CU; launching 1 per CU\n", per_cu);
    grid_blocks = cus;
    if (ws_size < WS_END) fprintf(stderr, "kernel_launch: workspace too small: %zu < %zu\n", ws_size, (size_t)WS_END);
    if (n_in != 20 || out_size != NT * DM) fprintf(stderr, "kernel_launch: unexpected shapes n_in=%d out=%d\n", n_in, out_size);
  }
  (void)hipMemsetAsync((char*)d_ws + OFF_BAR, 0, XCD_BAR_WORDS * 4, stream);
  Params p{};
  for (int i = 0; i < 20; ++i) p.in[i] = (const float*)d_in[i];
  p.X = (float*)d_out;
  p.ws = (unsigned char*)d_ws;
  p.ph_lo = 0; p.ph_hi = 1 << 20;
  void* args[] = {&p};
  hipError_t e = hipLaunchCooperativeKernel((void*)fwd_megakernel, dim3(grid_blocks), dim3(512), args, 0, stream);
  if (e != hipSuccess) fprintf(stderr, "cooperative launch failed: %s (grid %d)\n", hipGetErrorString(e), grid_blocks);
}
```

```cpp
#include <hip/hip_runtime.h>
#include <hip/hip_cooperative_groups.h>
#include <cstdio>
#include <cstdint>
namespace cg = cooperative_groups;

typedef unsigned short bf16_t;
typedef short bf16x8 __attribute__((ext_vector_type(8)));
typedef float f32x16 __attribute__((ext_vector_type(16)));
typedef float f32x4 __attribute__((ext_vector_type(4)));
typedef unsigned u32x4 __attribute__((ext_vector_type(4)));
typedef unsigned u32x2 __attribute__((ext_vector_type(2)));
typedef unsigned long long u64;

#define DI __device__ __forceinline__
#define MFMA32(a, b, c) __builtin_amdgcn_mfma_f32_32x32x16_bf16((a), (b), (c), 0, 0, 0)

#ifndef MK_PER_PHASE
#define MK_PER_PHASE 0
#endif

constexpr int NT = 32768, DM = 1024, DFF = 2816, SEQ = 4096;
constexpr int LDP_E = 2944, LDP_O = 2048;
constexpr int NPHASES = 45;

constexpr size_t OFF_XB = 0;
constexpr size_t OFF_Y = OFF_XB + (size_t)NT * DM * 2;
constexpr size_t OFF_R = OFF_Y + (size_t)NT * DM * 2;
constexpr size_t SZ_R = (size_t)NT * 3072 * 2;
constexpr size_t OFF_VTO = OFF_R + (size_t)NT * LDP_O * 2;
constexpr size_t OFF_VTS = OFF_R + SZ_R;
constexpr size_t OFF_VTW = OFF_VTS + (size_t)8 * 2 * 64 * 4096 * 2;
constexpr size_t OFF_HC = OFF_VTW + (size_t)8 * 2 * 64 * 4096 * 2;
constexpr size_t OFF_KC = OFF_HC + (size_t)2 * 4096 * 128 * 2;
constexpr size_t OFF_VCT = OFF_KC + (size_t)4096 * 64 * 2;
constexpr size_t OFF_BIAS = OFF_VCT + (size_t)4096 * 64 * 2;
constexpr size_t OFF_W = OFF_BIAS + 4096;
constexpr size_t E_FIN = (size_t)5632 * 1024, E_FOUT = (size_t)1024 * 2816, E_FFN = E_FIN + E_FOUT;
constexpr size_t E_AB = (size_t)3072 * 1024, E_ABO = (size_t)1024 * 1024, E_W1 = (size_t)128 * 2048, E_W2 = (size_t)128 * 128;
constexpr size_t E_EVEN = E_AB + E_ABO + 2 * E_W1 + 2 * E_W2;
constexpr size_t E_QKV = (size_t)3072 * 1024, E_ODD = E_QKV + E_ABO;
constexpr size_t OFF_WFFN = OFF_W;
constexpr size_t OFF_WEVEN = OFF_WFFN + 8 * E_FFN * 2;
constexpr size_t OFF_WODD = OFF_WEVEN + 2 * E_EVEN * 2;
constexpr size_t OFF_BAR = OFF_WODD + 2 * E_ODD * 2;
constexpr size_t WS_END = OFF_BAR + 16384;

struct Params {
  const float* in[20];
  float* X;
  unsigned char* ws;
  int ph_lo, ph_hi;
};

DI bf16_t f2bf(float x) { unsigned u = __float_as_uint(x); u += 0x7fffu + ((u >> 16) & 1u); return (bf16_t)(u >> 16); }
DI float bf2f(bf16_t v) { return __uint_as_float(((unsigned)v) << 16); }
typedef __bf16 hwbf16x2 __attribute__((ext_vector_type(2)));
typedef float f32x2 __attribute__((ext_vector_type(2)));
DI unsigned pack2(float a, float b) { f32x2 v = {a, b}; return __builtin_bit_cast(unsigned, __builtin_convertvector(v, hwbf16x2)); }
DI float bflo(unsigned u) { return __uint_as_float(u << 16); }
DI float bfhi(unsigned u) { return __uint_as_float(u & 0xffff0000u); }
DI float wave_sum(float v) {
#pragma unroll
  for (int o = 1; o < 64; o <<= 1) v += __shfl_xor(v, o);
  return v;
}
DI int otid() { int t = threadIdx.x; asm volatile("" : "+v"(t)); return t; }
DI void half_swap(float x, float& r0, float& r1) {
  const auto r = __builtin_amdgcn_permlane32_swap(__float_as_uint(x), __float_as_uint(x), false, false);
  r0 = __uint_as_float(r[0]); r1 = __uint_as_float(r[1]);
}
DI float half_max(float x) { float a, b; half_swap(x, a, b); return fmaxf(a, b); }
DI float half_sum(float x) { float a, b; half_swap(x, a, b); return a + b; }
DI float half_other(float x, int hh) { float a, b; half_swap(x, a, b); return hh ? a : b; }
DI int crow(int reg, int hh) { return (reg & 3) + 8 * (reg >> 2) + 4 * hh; }
DI float sigmoidf(float x) { return 1.f / (1.f + __expf(-x)); }
DI float gelu_tanh(float x) {
  float u = 0.7978845608028654f * (x + 0.044715f * x * x * x);
  float t = 1.f - 2.f / (1.f + __expf(2.f * u));
  return 0.5f * x * (1.f + t);
}

enum { EPI_SWIGLU = 0, EPI_RESID = 1, EPI_PROJ_EVEN = 2, EPI_PROJ_ODD = 3, EPI_CMP1 = 4, EPI_CMP2 = 5 };

struct GemmArgs {
  const bf16_t* A0; const bf16_t* A1; int lda; int aoff0, aoff1;
  const bf16_t* Bt0; const bf16_t* Bt1;
  int K, NTm, NTn, nmat, gm;
  void* out0; void* out1; void* out2;
  const float* src; float scale;
  const float* bias0; const float* bias1;
};

DI void tile_map(int id, int NTm, int NTn, int& mt, int& nt, int gm = 4) {
  const int x = id & 7, j = id >> 3;
  const int MX = NTm >> 3;
  const int GM = MX < gm ? MX : gm;
  const int per = GM * NTn;
  const int mg = j / per, r = j - mg * per;
  nt = r / GM;
  const int mi = r - nt * GM;
  mt = x * MX + mg * GM + mi;
}

constexpr int LDT = 72;
constexpr int GEMM_LDS = 2 * 2 * 128 * LDT * 2;
constexpr int LDS_BYTES = 2 * GEMM_LDS;

template <int EPI>
DI void gemm_tile(const GemmArgs& g, const int kv, const int mt, const int nt, char* lds, const int kt0 = 0, int kt1 = -1, float* red = nullptr, const int hfid = 0) {
  const int tid = otid() & 255, lane = tid & 63, wave = tid >> 6;
  const int wm = wave >> 1, wn = wave & 1, l32 = lane & 31, hh = lane >> 5;
  bf16_t* As = (bf16_t*)lds;
  bf16_t* Bs = As + 2 * 128 * LDT;
  const int m0 = mt * 128, n0 = nt * 128;
  const int K = g.K, nk = kt1 < 0 ? (K >> 6) : kt1;
  const int lr = tid >> 3, lc = (tid & 7) * 8;
  const bf16_t* Abase = kv ? g.A1 : g.A0;
  const int aoff = kv ? g.aoff1 : g.aoff0;
  const bf16_t* Bbase = (kv ? g.Bt1 : g.Bt0) + (size_t)(n0 + lr) * K + lc;

  auto aaddr = [&](int i, int kt) -> const bf16_t* {
    const int r = m0 + lr + 32 * i;
    if constexpr (EPI == EPI_CMP1) {
      const int bg = r >> 8; int n = r & 255; n = n > 254 ? 254 : n;
      const size_t tok = (size_t)(bg >> 1) * SEQ + 16 * n + kt;
      return Abase + tok * LDP_E + aoff + (bg & 1) * 64 + lc;
    } else {
      return Abase + (size_t)r * g.lda + kt * 64 + lc;
    }
  };

  f32x16 acc[2][2];
#pragma unroll
  for (int i = 0; i < 2; ++i)
#pragma unroll
    for (int j = 0; j < 2; ++j)
#pragma unroll
      for (int e = 0; e < 16; ++e) acc[i][j][e] = 0.f;

  u32x4 ra[4], rb[4];
#pragma unroll
  for (int i = 0; i < 4; ++i) { ra[i] = *(const u32x4*)aaddr(i, kt0); rb[i] = *(const u32x4*)(Bbase + (size_t)(32 * i) * K + kt0 * 64); }
#pragma unroll
  for (int i = 0; i < 4; ++i) { *(u32x4*)&As[(lr + 32 * i) * LDT + lc] = ra[i]; *(u32x4*)&Bs[(lr + 32 * i) * LDT + lc] = rb[i]; }
  __syncthreads();

  for (int kt = kt0; kt < nk; ++kt) {
    const int cur = (kt - kt0) & 1;
    if (kt + 1 < nk) {
#pragma unroll
      for (int i = 0; i < 4; ++i) { ra[i] = *(const u32x4*)aaddr(i, kt + 1); rb[i] = *(const u32x4*)(Bbase + (size_t)(32 * i) * K + (kt + 1) * 64); }
    }
    const bf16_t* as = As + cur * 128 * LDT + (wm * 64 + l32) * LDT + hh * 8;
    const bf16_t* bs = Bs + cur * 128 * LDT + (wn * 64 + l32) * LDT + hh * 8;
#pragma unroll
    for (int ks = 0; ks < 4; ++ks) {
      const bf16x8 a0 = *(const bf16x8*)(as + ks * 16);
      const bf16x8 a1 = *(const bf16x8*)(as + 32 * LDT + ks * 16);
      const bf16x8 b0 = *(const bf16x8*)(bs + ks * 16);
      const bf16x8 b1 = *(const bf16x8*)(bs + 32 * LDT + ks * 16);
      acc[0][0] = MFMA32(a0, b0, acc[0][0]);
      acc[0][1] = MFMA32(a0, b1, acc[0][1]);
      acc[1][0] = MFMA32(a1, b0, acc[1][0]);
      acc[1][1] = MFMA32(a1, b1, acc[1][1]);
    }
    if (kt + 1 < nk) {
      bf16_t* ad = As + (cur ^ 1) * 128 * LDT;
      bf16_t* bd = Bs + (cur ^ 1) * 128 * LDT;
#pragma unroll
      for (int i = 0; i < 4; ++i) { *(u32x4*)&ad[(lr + 32 * i) * LDT + lc] = ra[i]; *(u32x4*)&bd[(lr + 32 * i) * LDT + lc] = rb[i]; }
    }
    __syncthreads();
  }
  if (red) {
    if (hfid == 1) {
#pragma unroll
      for (int i = 0; i < 2; ++i)
#pragma unroll
        for (int j = 0; j < 2; ++j)
#pragma unroll
          for (int e = 0; e < 16; ++e) red[((i * 2 + j) * 16 + e) * 256 + tid] = acc[i][j][e];
    }
    __syncthreads();
    if (hfid == 0) {
#pragma unroll
      for (int i = 0; i < 2; ++i)
#pragma unroll
        for (int j = 0; j < 2; ++j)
#pragma unroll
          for (int e = 0; e < 16; ++e) acc[i][j][e] += red[((i * 2 + j) * 16 + e) * 256 + tid];
    }
    __syncthreads();
    if (hfid == 1) return;
  }

#pragma unroll
  for (int i = 0; i < 2; ++i) {
    const int rbase = m0 + wm * 64 + i * 32 + 4 * hh;
    if constexpr (EPI == EPI_SWIGLU) {
      bf16_t* H = (bf16_t*)g.out0;
      const int hc = ((n0 + wn * 64) >> 1) + l32;
#pragma unroll
      for (int e = 0; e < 16; ++e) {
        const int row = rbase + (e & 3) + 8 * (e >> 2);
        const float gt = acc[i][0][e], up = acc[i][1][e];
        H[(size_t)row * DFF + hc] = f2bf(gt / (1.f + __expf(-gt)) * up);
      }
    } else if constexpr (EPI == EPI_RESID) {
      float* X = (float*)g.out0;
      const float* __restrict__ src = g.src;
      const size_t ibase = (size_t)rbase * DM + n0 + wn * 64 + l32;
#pragma unroll
      for (int j = 0; j < 2; ++j)
#pragma unroll
        for (int e = 0; e < 16; ++e) {
          const float r = __builtin_nontemporal_load(src + ibase + (size_t)((e & 3) + 8 * (e >> 2)) * DM + j * 32);
          acc[i][j][e] = r + g.scale * acc[i][j][e];
        }
#pragma unroll
      for (int j = 0; j < 2; ++j)
#pragma unroll
        for (int e = 0; e < 16; ++e) X[ibase + (size_t)((e & 3) + 8 * (e >> 2)) * DM + j * 32] = acc[i][j][e];
    } else if constexpr (EPI == EPI_PROJ_EVEN) {
      if (n0 == 2432 || n0 == 2688) {
        bf16_t* VT = (bf16_t*)(n0 == 2432 ? g.out1 : g.out2);
#pragma unroll
        for (int j = 0; j < 2; ++j) {
          const int d = j * 32 + l32;
#pragma unroll
          for (int q4 = 0; q4 < 4; ++q4) {
            const int row = rbase + 8 * q4, b = row >> 12, t = row & 4095;
            u32x2 v; v.x = pack2(acc[i][j][4 * q4], acc[i][j][4 * q4 + 1]); v.y = pack2(acc[i][j][4 * q4 + 2], acc[i][j][4 * q4 + 3]);
            *(u32x2*)&VT[((size_t)((b * 2 + wn) * 64 + d)) * SEQ + t] = v;
          }
        }
      } else {
        bf16_t* P = (bf16_t*)g.out0;
#pragma unroll
        for (int j = 0; j < 2; ++j) {
          const int col = n0 + wn * 64 + j * 32 + l32;
          if (col < 2840) {
#pragma unroll
            for (int e = 0; e < 16; ++e) P[(size_t)(rbase + (e & 3) + 8 * (e >> 2)) * LDP_E + col] = f2bf(acc[i][j][e]);
          }
        }
      }
    } else if constexpr (EPI == EPI_PROJ_ODD) {
      if (n0 >= 2048) {
        bf16_t* VT = (bf16_t*)g.out1;
        const int hd = ((n0 - 2048) >> 6) + wn;
#pragma unroll
        for (int j = 0; j < 2; ++j) {
          const int d = j * 32 + l32;
#pragma unroll
          for (int q4 = 0; q4 < 4; ++q4) {
            const int row = rbase + 8 * q4, b = row >> 12, t = row & 4095;
            u32x2 v; v.x = pack2(acc[i][j][4 * q4], acc[i][j][4 * q4 + 1]); v.y = pack2(acc[i][j][4 * q4 + 2], acc[i][j][4 * q4 + 3]);
            *(u32x2*)&VT[((size_t)((b * 16 + hd) * 64 + d)) * SEQ + t] = v;
          }
        }
      } else {
        bf16_t* P = (bf16_t*)g.out0;
#pragma unroll
        for (int j = 0; j < 2; ++j) {
          const int col = n0 + wn * 64 + j * 32 + l32;
#pragma unroll
          for (int e = 0; e < 16; ++e) P[(size_t)(rbase + (e & 3) + 8 * (e >> 2)) * LDP_O + col] = f2bf(acc[i][j][e]);
        }
      }
    } else if constexpr (EPI == EPI_CMP1) {
      bf16_t* H = (bf16_t*)(kv ? g.out1 : g.out0);
      const float* bias = kv ? g.bias1 : g.bias0;
#pragma unroll
      for (int j = 0; j < 2; ++j) {
        const int col = wn * 64 + j * 32 + l32;
        const float bv = bias[col];
#pragma unroll
        for (int e = 0; e < 16; ++e) H[(size_t)(rbase + (e & 3) + 8 * (e >> 2)) * 128 + col] = f2bf(gelu_tanh(acc[i][j][e] + bv));
      }
    } else {
      if (wn == 0) {
#pragma unroll
        for (int j = 0; j < 2; ++j) {
          const int col = j * 32 + l32;
          if (kv == 0) {
            bf16_t* KC = (bf16_t*)g.out0;
#pragma unroll
            for (int e = 0; e < 16; ++e) KC[(size_t)(rbase + (e & 3) + 8 * (e >> 2)) * 64 + col] = f2bf(acc[i][j][e]);
          } else {
            bf16_t* VCT = (bf16_t*)g.out1;
#pragma unroll
            for (int q4 = 0; q4 < 4; ++q4) {
              const int row = rbase + 8 * q4;
              u32x2 v; v.x = pack2(acc[i][j][4 * q4], acc[i][j][4 * q4 + 1]); v.y = pack2(acc[i][j][4 * q4 + 2], acc[i][j][4 * q4 + 3]);
              *(u32x2*)&VCT[((size_t)((row >> 8) * 64 + col)) * 256 + (row & 255)] = v;
            }
          }
        }
      }
    }
  }
}

template <int EPI>
DI void gemm_pair_phase(const GemmArgs& g, char* lds) {
  const int per = g.NTm * g.NTn, total = per * g.nmat;
  const int hf = otid() >> 8;
  for (int id0 = blockIdx.x * 2; id0 < total; id0 += gridDim.x * 2) {
    const int id = id0 + hf;
    const int kv = id / per, idl = id - kv * per;
    int mt, nt; tile_map(idl, g.NTm, g.NTn, mt, nt);
    gemm_tile<EPI>(g, kv, mt, nt, lds + hf * GEMM_LDS);
  }
}

DI void convT(const float* __restrict__ src, int K, int N, int Npad, bf16_t* __restrict__ dst, const float* __restrict__ gain, int mode, char* lds) {
  const int tid512 = otid(), hf0 = tid512 >> 8, tid = tid512 & 255;
  float* tile = (float*)lds + hf0 * (64 * 65);
  const int tk = K >> 6, tn = Npad >> 6, total = tk * tn;
  for (int t0 = blockIdx.x * 2; t0 < total; t0 += gridDim.x * 2) {
    const int t = t0 + hf0;
    const bool act = t < total;
    const int kb = t / tn, nb = t - kb * tn, k0 = kb * 64, n0 = nb * 64;
    __syncthreads();
    if (act) {
      const int n4 = (tid & 15) * 4, n = n0 + n4;
      float sc = 1.f;
      if (mode == 2 && n >= 1536 && n < 2048) sc = 0.125f * 1.4426950408889634f;
      if (mode == 3 && n < 1024) sc = 0.125f * 1.4426950408889634f;
      f32x4 v[4];
#pragma unroll
      for (int i = 0; i < 4; ++i) {
        const int kk = (tid >> 4) + 16 * i;
        v[i] = (n < N) ? *(const f32x4*)&src[(size_t)(k0 + kk) * N + n] : f32x4{0.f, 0.f, 0.f, 0.f};
      }
#pragma unroll
      for (int i = 0; i < 4; ++i) {
        const int kk = (tid >> 4) + 16 * i;
        const float gs = gain ? gain[k0 + kk] * sc : sc;
        tile[kk * 65 + n4 + 0] = v[i].x * gs; tile[kk * 65 + n4 + 1] = v[i].y * gs;
        tile[kk * 65 + n4 + 2] = v[i].z * gs; tile[kk * 65 + n4 + 3] = v[i].w * gs;
      }
    }
    __syncthreads();
    if (act) {
      const int nn = tid >> 2, kc = (tid & 3) * 16, n = n0 + nn;
      int nrow = n;
      if (mode == 1) { const int hf = n >= DFF ? 1 : 0, j = n - hf * DFF; nrow = (j >> 4) * 32 + hf * 16 + (j & 15); }
      u32x4 o0, o1;
      o0.x = pack2(tile[(kc + 0) * 65 + nn], tile[(kc + 1) * 65 + nn]);
      o0.y = pack2(tile[(kc + 2) * 65 + nn], tile[(kc + 3) * 65 + nn]);
      o0.z = pack2(tile[(kc + 4) * 65 + nn], tile[(kc + 5) * 65 + nn]);
      o0.w = pack2(tile[(kc + 6) * 65 + nn], tile[(kc + 7) * 65 + nn]);
      o1.x = pack2(tile[(kc + 8) * 65 + nn], tile[(kc + 9) * 65 + nn]);
      o1.y = pack2(tile[(kc + 10) * 65 + nn], tile[(kc + 11) * 65 + nn]);
      o1.z = pack2(tile[(kc + 12) * 65 + nn], tile[(kc + 13) * 65 + nn]);
      o1.w = pack2(tile[(kc + 14) * 65 + nn], tile[(kc + 15) * 65 + nn]);
      bf16_t* d = dst + (size_t)nrow * K + k0 + kc;
      *(u32x4*)d = o0; *(u32x4*)(d + 8) = o1;
    }
  }
}

DI bf16_t* w_ffn_in(unsigned char* ws, int l, int f) { return (bf16_t*)(ws + OFF_WFFN) + (size_t)(l * 2 + f) * E_FFN; }
DI bf16_t* w_ffn_out(unsigned char* ws, int l, int f) { return w_ffn_in(ws, l, f) + E_FIN; }
DI bf16_t* w_ab(unsigned char* ws, int i) { return (bf16_t*)(ws + OFF_WEVEN) + (size_t)i * E_EVEN; }
DI bf16_t* w_abo(unsigned char* ws, int i) { return w_ab(ws, i) + E_AB; }
DI bf16_t* w_c1(unsigned char* ws, int i, int kv) { return w_abo(ws, i) + E_ABO + (size_t)kv * E_W1; }
DI bf16_t* w_c2(unsigned char* ws, int i, int kv) { return w_abo(ws, i) + E_ABO + 2 * E_W1 + (size_t)kv * E_W2; }
DI bf16_t* w_qkv(unsigned char* ws, int i) { return (bf16_t*)(ws + OFF_WODD) + (size_t)i * E_ODD; }
DI bf16_t* w_sbo(unsigned char* ws, int i) { return w_qkv(ws, i) + E_QKV; }

DI void prep_phase(const Params& p, char* lds) {
  unsigned char* ws = p.ws;
  for (int l = 0; l < 4; ++l) {
    for (int f = 0; f < 2; ++f) {
      const float* win = p.in[f ? 17 : 2] + (size_t)l * 1024 * 5632;
      const float* wout = p.in[f ? 18 : 3] + (size_t)l * 2816 * 1024;
      const float* gn = p.in[f ? 16 : 1] + l * 1024;
      convT(win, 1024, 5632, 5632, w_ffn_in(ws, l, f), gn, 1, lds);
      convT(wout, 2816, 1024, 1024, w_ffn_out(ws, l, f), nullptr, 0, lds);
    }
  }
  for (int i = 0; i < 2; ++i) {
    convT(p.in[5] + (size_t)i * 1024 * 2840, 1024, 2840, 3072, w_ab(ws, i), p.in[4] + (2 * i) * 1024, 2, lds);
    convT(p.in[13] + (size_t)i * 1024 * 1024, 1024, 1024, 1024, w_abo(ws, i), nullptr, 0, lds);
    for (int kv = 0; kv < 2; ++kv) {
      convT(p.in[kv ? 11 : 8] + (size_t)i * 2048 * 128, 2048, 128, 128, w_c1(ws, i, kv), nullptr, 0, lds);
      convT(p.in[kv ? 12 : 9] + (size_t)i * 128 * 64, 128, 64, 128, w_c2(ws, i, kv), nullptr, 0, lds);
    }
    convT(p.in[14] + (size_t)i * 1024 * 3072, 1024, 3072, 3072, w_qkv(ws, i), p.in[4] + (2 * i + 1) * 1024, 3, lds);
    convT(p.in[15] + (size_t)i * 1024 * 1024, 1024, 1024, 1024, w_sbo(ws, i), nullptr, 0, lds);
  }
  const int lane = otid() & 63, gw = blockIdx.x * 8 + (otid() >> 6), nw = gridDim.x * 8;
  float* bias = (float*)(ws + OFF_BIAS);
  for (int o = gw; o < 512; o += nw) {
    const int i = o >> 8, kv = (o >> 7) & 1, j = o & 127;
    const float* pe = p.in[kv ? 10 : 7] + (size_t)i * 2048;
    const float* w1 = p.in[kv ? 11 : 8] + (size_t)i * 2048 * 128;
    float s = 0.f;
    for (int k = lane; k < 2048; k += 64) s += pe[k] * w1[(size_t)k * 128 + j];
    s = wave_sum(s);
    if (lane == 0) bias[o] = s;
  }
}

DI void rownorm_phase(const float* __restrict__ src, bf16_t* __restrict__ dst) {
  const int lane = otid() & 63, gw = blockIdx.x * 8 + (otid() >> 6), nw = gridDim.x * 8;
  for (int row = gw; row < NT; row += nw) {
    const f32x4* xr = (const f32x4*)(src + (size_t)row * DM) + lane;
    f32x4 v[4]; float s = 0.f;
#pragma unroll
    for (int j = 0; j < 4; ++j) { v[j] = xr[64 * j]; s += v[j].x * v[j].x + v[j].y * v[j].y + v[j].z * v[j].z + v[j].w * v[j].w; }
    s = wave_sum(s);
    const float rstd = rsqrtf(s * (1.f / DM) + 1e-6f);
    u32x2* o = (u32x2*)(dst + (size_t)row * DM) + lane;
#pragma unroll
    for (int j = 0; j < 4; ++j) { u32x2 w; w.x = pack2(v[j].x * rstd, v[j].y * rstd); w.y = pack2(v[j].z * rstd, v[j].w * rstd); o[64 * j] = w; }
  }
}
DI void finalnorm_phase(float* __restrict__ X, const float* __restrict__ gain) {
  const int lane = otid() & 63, gw = blockIdx.x * 8 + (otid() >> 6), nw = gridDim.x * 8;
  for (int row = gw; row < NT; row += nw) {
    f32x4* xr = (f32x4*)(X + (size_t)row * DM) + lane;
    const f32x4* gr = (const f32x4*)gain + lane;
    f32x4 v[4]; float s = 0.f;
#pragma unroll
    for (int j = 0; j < 4; ++j) { v[j] = xr[64 * j]; s += v[j].x * v[j].x + v[j].y * v[j].y + v[j].z * v[j].z + v[j].w * v[j].w; }
    s = wave_sum(s);
    const float rstd = rsqrtf(s * (1.f / DM) + 1e-6f);
#pragma unroll
    for (int j = 0; j < 4; ++j) { const f32x4 gg = gr[64 * j]; f32x4 w; w.x = v[j].x * rstd * gg.x; w.y = v[j].y * rstd * gg.y; w.z = v[j].z * rstd * gg.z; w.w = v[j].w * rstd * gg.w; xr[64 * j] = w; }
  }
}

DI void conv_item(const bf16_t* __restrict__ P, const float* __restrict__ cw, bf16_t* __restrict__ Y, int item) {
  const int tid = otid() & 255;
  const int t0 = item * 32 + (tid >> 6) * 8, c0 = (tid & 63) * 8;
  const int tb = t0 & (SEQ - 1);
  float w0[8], w1[8], w2[8], u1[8], u2[8];
#pragma unroll
  for (int e = 0; e < 8; ++e) { w0[e] = cw[c0 + e]; w1[e] = cw[512 + c0 + e]; w2[e] = cw[1024 + c0 + e]; u1[e] = 0.f; u2[e] = 0.f; }
  if (tb >= 1) {
    const bf16_t* r = P + (size_t)(t0 - 1) * LDP_E + c0;
    const u32x4 c = *(const u32x4*)(r + 512), h = *(const u32x4*)(r + 1024);
    u1[0] = bflo(c.x) * bflo(h.x); u1[1] = bfhi(c.x) * bfhi(h.x); u1[2] = bflo(c.y) * bflo(h.y); u1[3] = bfhi(c.y) * bfhi(h.y);
    u1[4] = bflo(c.z) * bflo(h.z); u1[5] = bfhi(c.z) * bfhi(h.z); u1[6] = bflo(c.w) * bflo(h.w); u1[7] = bfhi(c.w) * bfhi(h.w);
  }
  if (tb >= 2) {
    const bf16_t* r = P + (size_t)(t0 - 2) * LDP_E + c0;
    const u32x4 c = *(const u32x4*)(r + 512), h = *(const u32x4*)(r + 1024);
    u2[0] = bflo(c.x) * bflo(h.x); u2[1] = bfhi(c.x) * bfhi(h.x); u2[2] = bflo(c.y) * bflo(h.y); u2[3] = bfhi(c.y) * bfhi(h.y);
    u2[4] = bflo(c.z) * bflo(h.z); u2[5] = bfhi(c.z) * bfhi(h.z); u2[6] = bflo(c.w) * bflo(h.w); u2[7] = bfhi(c.w) * bfhi(h.w);
  }
#pragma unroll
  for (int tt = 0; tt < 8; ++tt) {
    const bf16_t* r = P + (size_t)(t0 + tt) * LDP_E + c0;
    const u32x4 bq = *(const u32x4*)r, c = *(const u32x4*)(r + 512), h = *(const u32x4*)(r + 1024);
    float u0[8], bb[8], y[8];
    u0[0] = bflo(c.x) * bflo(h.x); u0[1] = bfhi(c.x) * bfhi(h.x); u0[2] = bflo(c.y) * bflo(h.y); u0[3] = bfhi(c.y) * bfhi(h.y);
    u0[4] = bflo(c.z) * bflo(h.z); u0[5] = bfhi(c.z) * bfhi(h.z); u0[6] = bflo(c.w) * bflo(h.w); u0[7] = bfhi(c.w) * bfhi(h.w);
    bb[0] = bflo(bq.x); bb[1] = bfhi(bq.x); bb[2] = bflo(bq.y); bb[3] = bfhi(bq.y); bb[4] = bflo(bq.z); bb[5] = bfhi(bq.z); bb[6] = bflo(bq.w); bb[7] = bfhi(bq.w);
#pragma unroll
    for (int e = 0; e < 8; ++e) { y[e] = bb[e] * (w0[e] * u2[e] + w1[e] * u1[e] + w2[e] * u0[e]); u2[e] = u1[e]; u1[e] = u0[e]; }
    u32x4 o; o.x = pack2(y[0], y[1]); o.y = pack2(y[2], y[3]); o.z = pack2(y[4], y[5]); o.w = pack2(y[6], y[7]);
    *(u32x4*)&Y[(size_t)(t0 + tt) * DM + c0] = o;
  }
}

DI void load_tile64(bf16_t* dst, const bf16_t* __restrict__ src, size_t stride) {
  const int c = otid(), row = c >> 3, col = (c & 7) * 8;
  *(u32x4*)&dst[row * LDT + col] = *(const u32x4*)&src[(size_t)row * stride + col];
}
DI u32x4 tile_fetch(const bf16_t* __restrict__ src, size_t stride) {
  const int c = otid(), row = c >> 3, col = (c & 7) * 8;
  return *(const u32x4*)&src[(size_t)row * stride + col];
}
DI void tile_commit(bf16_t* dst, const u32x4& v) {
  const int c = otid(), row = c >> 3, col = (c & 7) * 8;
  *(u32x4*)&dst[row * LDT + col] = v;
}
DI void qk_tile(const bf16_t* Ks, const bf16x8 (&qf)[4], f32x16 (&S)[2], int l32, int hh) {
  bf16x8 kf[2][4];
#pragma unroll
  for (int kt2 = 0; kt2 < 2; ++kt2)
#pragma unroll
    for (int s = 0; s < 4; ++s) kf[kt2][s] = *(const bf16x8*)&Ks[(kt2 * 32 + l32) * LDT + s * 16 + hh * 8];
  __builtin_amdgcn_sched_barrier(0);
#pragma unroll
  for (int kt2 = 0; kt2 < 2; ++kt2)
#pragma unroll
    for (int e = 0; e < 16; ++e) S[kt2][e] = 0.f;
#pragma unroll
  for (int s = 0; s < 4; ++s)
#pragma unroll
    for (int kt2 = 0; kt2 < 2; ++kt2) S[kt2] = MFMA32(kf[kt2][s], qf[s], S[kt2]);
}
DI void pv_tile(const bf16_t* VTs, const f32x16 (&Pm)[2], f32x16 (&O)[2], int l32, int hh) {
#pragma unroll
  for (int kt2 = 0; kt2 < 2; ++kt2) {
    u32x2 lo[2][2], hi[2][2];
#pragma unroll
    for (int t = 0; t < 2; ++t)
#pragma unroll
      for (int dt = 0; dt < 2; ++dt) {
        const bf16_t* vp = &VTs[(dt * 32 + l32) * LDT + kt2 * 32 + 16 * t + 4 * hh];
        lo[t][dt] = *(const u32x2*)vp; hi[t][dt] = *(const u32x2*)(vp + 8);
      }
    __builtin_amdgcn_sched_barrier(0);
#pragma unroll
    for (int t = 0; t < 2; ++t) {
      u32x4 pk;
      pk.x = pack2(Pm[kt2][8 * t + 0], Pm[kt2][8 * t + 1]); pk.y = pack2(Pm[kt2][8 * t + 2], Pm[kt2][8 * t + 3]);
      pk.z = pack2(Pm[kt2][8 * t + 4], Pm[kt2][8 * t + 5]); pk.w = pack2(Pm[kt2][8 * t + 6], Pm[kt2][8 * t + 7]);
      const bf16x8 pf = __builtin_bit_cast(bf16x8, pk);
#pragma unroll
      for (int dt = 0; dt < 2; ++dt) {
        u32x4 vv; vv.x = lo[t][dt].x; vv.y = lo[t][dt].y; vv.z = hi[t][dt].x; vv.w = hi[t][dt].y;
        O[dt] = MFMA32(__builtin_bit_cast(bf16x8, vv), pf, O[dt]);
      }
    }
  }
}
DI float ex2(float x) { return __builtin_amdgcn_exp2f(x); }
template <bool HAS_O>
DI void softmax_finish(f32x16 (&S)[2], float mx, float cbias, float& m, float& l, f32x16 (&O)[2]) {
  mx = half_max(mx);
  const float mn = (mx > m + 8.f) ? mx : m;
  const float alpha = ex2(m - mn);
  m = mn;
  const float c = mn + cbias;
  float sum = 0.f;
#pragma unroll
  for (int kt2 = 0; kt2 < 2; ++kt2)
#pragma unroll
    for (int e = 0; e < 16; ++e) { const float pv = ex2(S[kt2][e] - c); S[kt2][e] = pv; sum += pv; }
  l = l * alpha + sum;
  if constexpr (HAS_O) {
    if (__ballot(alpha != 1.f) != 0ull) {
#pragma unroll
      for (int dt = 0; dt < 2; ++dt)
#pragma unroll
        for (int e = 0; e < 16; ++e) O[dt][e] *= alpha;
    }
  }
}
template <bool HAS_O, class MaskF>
DI void softmax_step(f32x16 (&S)[2], float& m, float& l, f32x16 (&O)[2], int hh, MaskF mask) {
  float mx = -1e30f;
#pragma unroll
  for (int kt2 = 0; kt2 < 2; ++kt2)
#pragma unroll
    for (int e = 0; e < 16; ++e) {
      const float sv = mask(kt2 * 32 + crow(e, hh)) ? S[kt2][e] : -1e30f;
      S[kt2][e] = sv; mx = fmaxf(mx, sv);
    }
  softmax_finish<HAS_O>(S, mx, 0.f, m, l, O);
}
template <bool HAS_O>
DI void softmax_fast(f32x16 (&S)[2], float& m, float& l, f32x16 (&O)[2], bool live) {
  float mx = S[0][0];
#pragma unroll
  for (int kt2 = 0; kt2 < 2; ++kt2)
#pragma unroll
    for (int e = 0; e < 16; ++e) mx = fmaxf(mx, S[kt2][e]);
  softmax_finish<HAS_O>(S, live ? mx : -1e30f, live ? 0.f : 1e30f, m, l, O);
}

constexpr int NSA_SLAB_OFF = 8 * 64 * LDT * 2;
constexpr int NSA_SELM_OFF = NSA_SLAB_OFF + 4 * 64 * 64 * 4;
DI void nsa_item(const bf16_t* __restrict__ P, const bf16_t* __restrict__ KC, const bf16_t* __restrict__ VCT,
                 const bf16_t* __restrict__ VTS, const bf16_t* __restrict__ VTW, bf16_t* __restrict__ Y, int item, char* lds) {
  const int tid = otid(), lane = tid & 63, wave = tid >> 6, l32 = lane & 31, hh = lane >> 5;
  const int xq = (item >> 4) & 15, rnd = item >> 8;
  const int qb = rnd == 0 ? 63 - xq : (rnd == 1 ? xq : (rnd == 2 ? 47 - xq : 16 + xq));
  const int bg = item & 15, b = bg >> 1, g = bg & 1;
  const int hr = wave & 3, qh = wave >> 2;
  const int q0 = qb * 64, cur = qb, pos = q0 + qh * 32 + l32, h = g * 4 + hr;
  const size_t tokbase = (size_t)b * SEQ;
  bf16_t* Ks = (bf16_t*)lds;
  bf16_t* VTs = Ks + 64 * LDT;
  float* slab = (float*)(lds + NSA_SLAB_OFF);
  u64* selm = (u64*)(lds + NSA_SELM_OFF);

  bf16x8 qf[4];
  {
    const bf16_t* qp = P + (tokbase + pos) * LDP_E + 1536 + h * 64 + hh * 8;
#pragma unroll
    for (int s = 0; s < 4; ++s) qf[s] = *(const bf16x8*)(qp + s * 16);
  }
  float g0, g1, g2;
  {
    const bf16_t* gp = P + (tokbase + pos) * LDP_E + 2816 + h * 3;
    g0 = sigmoidf(bf2f(gp[0])); g1 = sigmoidf(bf2f(gp[1])); g2 = sigmoidf(bf2f(gp[2]));
  }
  f32x16 O[2], S[2];
#pragma unroll
  for (int dt = 0; dt < 2; ++dt)
#pragma unroll
    for (int e = 0; e < 16; ++e) O[dt][e] = 0.f;

  const int nct = (((q0 + 32) >> 4) >> 6) + 1;
  const bf16_t* kcb = KC + (size_t)bg * 256 * 64;
  const bf16_t* vcb = VCT + (size_t)bg * 64 * 256;
  float m = -1e29f, l = 0.f;
  u32x4 pfk = tile_fetch(kcb, 64), pfv = pfk;
#pragma unroll 1
  for (int ct = 0; ct < nct; ++ct) {
    __syncthreads();
    tile_commit(Ks, pfk);
    __syncthreads();
    { const int cn = ct + 1 < nct ? ct + 1 : 0;
      pfk = tile_fetch(kcb + (size_t)cn * 64 * 64, 64); pfv = tile_fetch(vcb + cn * 64, 256);
      __builtin_amdgcn_sched_barrier(0); }
    qk_tile(Ks, qf, S, l32, hh);
    softmax_step<false>(S, m, l, O, hh, [&](int kk) { return 16 * (ct * 64 + kk) + 31 <= pos; });
  }
  {
    const float lt = half_sum(l);
    const float inv = lt > 0.f ? 1.f / lt : 0.f;
    float carry3 = 0.f;
    float* myslab = slab + (hr * 64 + qh * 32 + l32) * 64;
#pragma unroll 1
    for (int ct = 0; ct < nct; ++ct) {
      __syncthreads();
      tile_commit(Ks, pfk); tile_commit(VTs, pfv);
      __syncthreads();
      { const int cn = ct + 1 < nct ? ct + 1 : ct;
        pfk = tile_fetch(kcb + (size_t)cn * 64 * 64, 64); pfv = tile_fetch(vcb + cn * 64, 256);
        __builtin_amdgcn_sched_barrier(0); }
      qk_tile(Ks, qf, S, l32, hh);
#pragma unroll
      for (int kt2 = 0; kt2 < 2; ++kt2) {
#pragma unroll
        for (int e = 0; e < 16; ++e) {
          const bool ok = 16 * (ct * 64 + kt2 * 32 + crow(e, hh)) + 31 <= pos;
          S[kt2][e] = ok ? ex2(S[kt2][e] - m) * inv : 0.f;
        }
        float x[4];
#pragma unroll
        for (int j = 0; j < 4; ++j) x[j] = half_other(S[kt2][4 * j + 3], hh);
#pragma unroll
        for (int j = 0; j < 4; ++j) {
          const float prev3 = hh ? x[j] : (j > 0 ? x[j - 1] : carry3);
          const float own = S[kt2][4 * j] + S[kt2][4 * j + 1] + S[kt2][4 * j + 2] + 0.5f * S[kt2][4 * j + 3] + 0.5f * prev3;
          myslab[ct * 16 + kt2 * 8 + 2 * j + hh] = own;
        }
        carry3 = x[3];
#pragma unroll
        for (int e = 0; e < 16; ++e) S[kt2][e] *= g0;
      }
      pv_tile(VTs, S, O, l32, hh);
    }
  }
  __syncthreads();
  {
    const int q = tid >> 3, sub = tid & 7;
    float v[8];
#pragma unroll
    for (int e = 0; e < 8; ++e) {
      const int s = sub * 8 + e;
      v[e] = 0.f;
      if (s <= cur) v[e] = slab[(0 * 64 + q) * 64 + s] + slab[(1 * 64 + q) * 64 + s] + slab[(2 * 64 + q) * 64 + s] + slab[(3 * 64 + q) * 64 + s];
    }
    __syncthreads();
#pragma unroll
    for (int e = 0; e < 8; ++e) { const int s = sub * 8 + e; if (s <= cur) slab[q * 64 + s] = v[e]; }
    __syncthreads();
    unsigned bits = 0;
    if (cur + 1 <= 16) {
#pragma unroll
      for (int e = 0; e < 8; ++e) if (sub * 8 + e <= cur) bits |= 1u << e;
    } else {
      int rank[8];
      u64 key[8];
#pragma unroll
      for (int e = 0; e < 8; ++e) { rank[e] = 0; key[e] = ((u64)__float_as_uint(v[e]) << 32) | (u64)(unsigned)(63 - (sub * 8 + e)); }
#pragma unroll 1
      for (int s2 = 1; s2 <= cur - 2; ++s2) {
        const u64 k2 = ((u64)__float_as_uint(slab[q * 64 + s2]) << 32) | (u64)(unsigned)(63 - s2);
#pragma unroll
        for (int e = 0; e < 8; ++e) rank[e] += (k2 > key[e]) ? 1 : 0;
      }
#pragma unroll
      for (int e = 0; e < 8; ++e) {
        const int s = sub * 8 + e;
        const bool forced = (s == 0) || (s == cur) || (s == cur - 1);
        if (s <= cur && (forced || rank[e] < 13)) bits |= 1u << e;
      }
    }
    unsigned lo = sub < 4 ? (bits << (8 * sub)) : 0u, hi = sub >= 4 ? (bits << (8 * (sub - 4))) : 0u;
#pragma unroll
    for (int o = 1; o < 8; o <<= 1) { lo |= __shfl_xor(lo, o); hi |= __shfl_xor(hi, o); }
    if (sub == 0) selm[q] = ((u64)hi << 32) | lo;
  }
  __syncthreads();
  u64 um = 0;
#pragma unroll 4
  for (int q = 0; q < 64; ++q) um |= selm[q];
  const u64 mym = selm[qh * 32 + l32];
  float* stash = slab + tid;
#pragma unroll
  for (int dt = 0; dt < 2; ++dt)
#pragma unroll
    for (int e = 0; e < 16; ++e) { stash[(dt * 16 + e) * 512] = O[dt][e]; O[dt][e] = 0.f; }

  const bf16_t* ks0 = P + tokbase * LDP_E + 2304 + g * 64;
  const bf16_t* vs0 = VTS + (size_t)bg * 64 * SEQ;
  const bf16_t* kw0 = P + tokbase * LDP_E + 2560 + g * 64;
  const bf16_t* vw0 = VTW + (size_t)bg * 64 * SEQ;
  const int kbs = cur - 8 > 0 ? cur - 8 : 0;
  m = -1e29f; l = 0.f;
  {
    constexpr int TS = 64 * LDT;
    u64 rem = um;
    int sk = 0, si = 0;
    auto advance = [&]() {
      if (sk == 0) { if (rem) { si = __builtin_ctzll(rem); rem &= rem - 1; } else { sk = 1; si = kbs; } }
      else if (sk == 1) { if (si < cur) ++si; else sk = 2; }
    };
    u32x4 pfk1 = pfk, pfv1 = pfv;
    auto fetch1 = [&](int kd, int ix, u32x4& rk, u32x4& rv) {
      const int iv = kd < 2 ? ix : 0;
      const bf16_t* kp = (kd == 0 ? ks0 : kw0) + (size_t)iv * 64 * LDP_E;
      const bf16_t* vp = (kd == 0 ? vs0 : vw0) + iv * 64;
      rk = tile_fetch(kp, LDP_E); rv = tile_fetch(vp, SEQ);
    };
    auto do_tile = [&](int kd, int ix, const bf16_t* kbuf, int knext) {
      qk_tile(kbuf, qf, S, l32, hh);
      if (kd == 0) {
        const bool mine = (mym >> ix) & 1ull;
        if (ix < cur) softmax_fast<true>(S, m, l, O, mine);
        else softmax_step<true>(S, m, l, O, hh, [&](int kk) { return mine && (ix * 64 + kk <= pos); });
      } else {
        if (ix < cur && ix > cur - 8) softmax_fast<true>(S, m, l, O, true);
        else softmax_step<true>(S, m, l, O, hh, [&](int kk) { const int kp = ix * 64 + kk; return kp <= pos && kp > pos - 512; });
      }
      pv_tile(kbuf + TS, S, O, l32, hh);
      if (kd == 0 && knext != 0) {
        const float lt = half_sum(l);
        const float sc = lt > 0.f ? g1 / lt : 0.f;
#pragma unroll
        for (int dt = 0; dt < 2; ++dt)
#pragma unroll
          for (int e = 0; e < 16; ++e) { stash[(dt * 16 + e) * 512] += O[dt][e] * sc; O[dt][e] = 0.f; }
        m = -1e29f; l = 0.f;
      }
    };
    sk = 0; si = __builtin_ctzll(rem); rem &= rem - 1;
    int ka0 = sk, ia0 = si; advance(); int ka1 = sk, ia1 = si;
    fetch1(ka0, ia0, pfk, pfv); fetch1(ka1, ia1, pfk1, pfv1);
    __syncthreads();
    tile_commit(Ks, pfk); tile_commit(Ks + TS, pfv); tile_commit(Ks + 2 * TS, pfk1); tile_commit(Ks + 3 * TS, pfv1);
    advance(); int kb0_ = sk, ib0 = si; advance(); int kb1_ = sk, ib1 = si;
    fetch1(kb0_, ib0, pfk, pfv); fetch1(kb1_, ib1, pfk1, pfv1);
    __syncthreads();
    int par = 0;
#pragma unroll 1
    for (;;) {
      const bf16_t* bcur = Ks + par * (4 * TS);
      bf16_t* bnxt = Ks + (par ^ 1) * (4 * TS);
      tile_commit(bnxt, pfk); tile_commit(bnxt + TS, pfv); tile_commit(bnxt + 2 * TS, pfk1); tile_commit(bnxt + 3 * TS, pfv1);
      advance(); const int kc0 = sk, ic0 = si; advance(); const int kc1 = sk, ic1 = si;
      fetch1(kc0, ic0, pfk, pfv); fetch1(kc1, ic1, pfk1, pfv1);
      __builtin_amdgcn_sched_barrier(0);
      do_tile(ka0, ia0, bcur, ka1);
      if (ka1 < 2) do_tile(ka1, ia1, bcur + 2 * TS, kb0_);
      if (kb0_ == 2) break;
      __syncthreads();
      ka0 = kb0_; ia0 = ib0; ka1 = kb1_; ia1 = ib1; kb0_ = kc0; ib0 = ic0; kb1_ = kc1; ib1 = ic1; par ^= 1;
    }
    const float lt = half_sum(l);
    const float sc = lt > 0.f ? g2 / lt : 0.f;
#pragma unroll
    for (int dt = 0; dt < 2; ++dt)
#pragma unroll
      for (int e = 0; e < 16; ++e) O[dt][e] = stash[(dt * 16 + e) * 512] + O[dt][e] * sc;
  }
  bf16_t* yp = Y + (tokbase + pos) * DM + 512 + h * 64 + 4 * hh;
#pragma unroll
  for (int dt = 0; dt < 2; ++dt)
#pragma unroll
    for (int j = 0; j < 4; ++j) {
      u32x2 v; v.x = pack2(O[dt][4 * j], O[dt][4 * j + 1]); v.y = pack2(O[dt][4 * j + 2], O[dt][4 * j + 3]);
      *(u32x2*)(yp + dt * 32 + 8 * j) = v;
    }
}

DI void sb_item(const bf16_t* __restrict__ P, const bf16_t* __restrict__ VT, bf16_t* __restrict__ Y, int item, char* lds) {
  const int tid = otid(), lane = tid & 63, wave = tid >> 6, l32 = lane & 31, hh = lane >> 5;
  const int qb = item & 15, bh = item >> 4, b = bh >> 4, hd = bh & 15;
  const int q0 = qb * 256 + wave * 32, qpos = q0 + l32;
  const size_t tokbase = (size_t)b * SEQ;
  bf16_t* Ks = (bf16_t*)lds;
  bf16_t* VTs = Ks + 64 * LDT;
  bf16x8 qf[4];
  {
    const bf16_t* qp = P + (tokbase + qpos) * LDP_O + hd * 64 + hh * 8;
#pragma unroll
    for (int s = 0; s < 4; ++s) qf[s] = *(const bf16x8*)(qp + s * 16);
  }
  f32x16 O[2], S[2];
#pragma unroll
  for (int dt = 0; dt < 2; ++dt)
#pragma unroll
    for (int e = 0; e < 16; ++e) O[dt][e] = 0.f;
  float carry = 1.f;
  const bf16_t* kb0 = P + tokbase * LDP_O + 1024 + hd * 64;
  const bf16_t* vb0 = VT + (size_t)bh * 64 * SEQ;
  const int kbs = 4 * qb + 3;
  constexpr int TS = 64 * LDT;
  u32x4 pfk = tile_fetch(kb0 + (size_t)kbs * 64 * LDP_O, LDP_O), pfv = tile_fetch(vb0 + kbs * 64, SEQ);
  u32x4 pfk1 = tile_fetch(kb0 + (size_t)(kbs - 1) * 64 * LDP_O, LDP_O), pfv1 = tile_fetch(vb0 + (kbs - 1) * 64, SEQ);
  __syncthreads();
  tile_commit(Ks, pfk); tile_commit(Ks + TS, pfv); tile_commit(Ks + 2 * TS, pfk1); tile_commit(Ks + 3 * TS, pfv1);
  if (kbs >= 3) {
    pfk = tile_fetch(kb0 + (size_t)(kbs - 2) * 64 * LDP_O, LDP_O); pfv = tile_fetch(vb0 + (kbs - 2) * 64, SEQ);
    pfk1 = tile_fetch(kb0 + (size_t)(kbs - 3) * 64 * LDP_O, LDP_O); pfv1 = tile_fetch(vb0 + (kbs - 3) * 64, SEQ);
  }
  __syncthreads();
  int par = 0, fi = 0;
  volatile int* flags = (volatile int*)(lds + LDS_BYTES + 16);
  auto do_tile = [&](int kb, const bf16_t* kcur) {
    const bool active = (kb * 64 < q0 + 31) && (__ballot(carry > 0.f) != 0ull);
    if (active) {
      qk_tile(kcur, qf, S, l32, hh);
      const bool full = kb * 64 + 63 < q0;
#pragma unroll
      for (int kt2 = 1; kt2 >= 0; --kt2) {
        float st[16];
#pragma unroll
        for (int e = 0; e < 16; ++e) {
          const float ez = ex2(S[kt2][e]);
          const float r = __builtin_amdgcn_rcpf(1.f + ez);
          const bool vis = full || (kb * 64 + kt2 * 32 + crow(e, hh) < qpos);
          st[e] = vis ? r : 1.f;
          S[kt2][e] = vis ? 1.f - r : 0.f;
        }
        float G[4], Go[4];
#pragma unroll
        for (int j = 0; j < 4; ++j) { G[j] = (st[4 * j] * st[4 * j + 1]) * (st[4 * j + 2] * st[4 * j + 3]); Go[j] = half_other(G[j], hh); }
        float T = carry;
#pragma unroll
        for (int j = 3; j >= 0; --j) {
          float run = hh ? T : T * Go[j];
#pragma unroll
          for (int e = 3; e >= 0; --e) {
            const int idx = 4 * j + e;
            S[kt2][idx] *= run;
            run *= st[idx];
          }
          T *= G[j] * Go[j];
        }
        carry = T;
      }
      pv_tile(kcur + TS, S, O, l32, hh);
    }
  };
#pragma unroll 1
  for (int kb = kbs; kb >= 1; kb -= 2) {
    const bf16_t* bcur = Ks + par * (4 * TS);
    bf16_t* bnxt = Ks + (par ^ 1) * (4 * TS);
    tile_commit(bnxt, pfk); tile_commit(bnxt + TS, pfv); tile_commit(bnxt + 2 * TS, pfk1); tile_commit(bnxt + 3 * TS, pfv1);
    {
      const int f0 = kb >= 5 ? kb - 4 : 1, f1 = kb >= 5 ? kb - 5 : 0;
      pfk = tile_fetch(kb0 + (size_t)f0 * 64 * LDP_O, LDP_O); pfv = tile_fetch(vb0 + f0 * 64, SEQ);
      pfk1 = tile_fetch(kb0 + (size_t)f1 * 64 * LDP_O, LDP_O); pfv1 = tile_fetch(vb0 + f1 * 64, SEQ);
      __builtin_amdgcn_sched_barrier(0); }
    par ^= 1;
    do_tile(kb, bcur);
    do_tile(kb - 1, bcur + 2 * TS);
    if (carry > 0.f) flags[fi] = 1;
    __syncthreads();
    const int cont = flags[fi];
    const int fz = fi >= 1 ? fi - 1 : 2;
    if (tid == 0) flags[fz] = 0;
    fi = fi == 2 ? 0 : fi + 1;
    if (!cont) break;
  }
  bf16_t* yp = Y + (tokbase + qpos) * DM + hd * 64 + 4 * hh;
#pragma unroll
  for (int dt = 0; dt < 2; ++dt)
#pragma unroll
    for (int j = 0; j < 4; ++j) {
      u32x2 v; v.x = pack2(O[dt][4 * j], O[dt][4 * j + 1]); v.y = pack2(O[dt][4 * j + 2], O[dt][4 * j + 3]);
      *(u32x2*)(yp + dt * 32 + 8 * j) = v;
    }
}


#define XB_TMO      128
#define XB_XCNT(j)  (256  + 64 * (j))
#define XB_XSUB(j)  (1280 + 64 * (j))
#define XB_XGEN(j)  (2304 + 64 * (j))
#define XB_TOP      3328
#define XB_TOPGEN   3392
#define XCD_BAR_WORDS 3456
#define XB_SPIN_CAP (1u << 22)
#define LAS __attribute__((address_space(3)))
DI unsigned xb_ld(unsigned* p) { return __hip_atomic_load(p, __ATOMIC_RELAXED, __HIP_MEMORY_SCOPE_AGENT); }
DI unsigned xb_add(unsigned* p, unsigned v) { return __hip_atomic_fetch_add(p, v, __ATOMIC_RELAXED, __HIP_MEMORY_SCOPE_AGENT); }
DI unsigned xb_xcc_id() { return (unsigned)__builtin_amdgcn_s_getreg((3 << 11) | 20) & 0xFu; }
#define XB_SPIN(cond, bar) do { unsigned _sp = 0; while (cond) { \
    if ((++_sp & 255u) == 0u) { if (xb_ld(&(bar)[XB_TMO])) break; if (_sp > XB_SPIN_CAP) { atomicAdd(&(bar)[XB_TMO], 1u); break; } } } } while (0)
struct XcdBarrier { unsigned* bar; unsigned x; volatile LAS unsigned* st; };
DI XcdBarrier xcd_barrier_post(unsigned* bar, volatile LAS unsigned* st) {
  XcdBarrier b; b.bar = bar; b.x = xb_xcc_id(); b.st = st;
  if (threadIdx.x == 0) (void)xb_add(&bar[XB_XCNT(b.x)], 1u);
  return b;
}
DI void xcd_barrier_complete(unsigned* bar, unsigned x, unsigned& nloc, unsigned& nx) {
  const unsigned G = gridDim.x * gridDim.y * gridDim.z;
  unsigned sum, cnt, mine, sp = 0u;
  for (;;) {
    sum = 0u; cnt = 0u; mine = 0u;
#pragma unroll
    for (unsigned j = 0; j < 16; ++j) { const unsigned c = xb_ld(&bar[XB_XCNT(j)]); sum += c; cnt += (c > 0u) ? 1u : 0u; mine = (j == x) ? c : mine; }
    if (sum == G) break;
    __builtin_amdgcn_s_sleep(1);
    if ((++sp & 255u) == 0u) { if (xb_ld(&bar[XB_TMO])) break; if (sp > XB_SPIN_CAP) { atomicAdd(&bar[XB_TMO], 1u); break; } }
  }
  nloc = mine > 0u ? mine : 1u; nx = cnt > 0u ? cnt : 1u;
}
DI void xcd_barrier(const XcdBarrier& b) {
  asm volatile("s_waitcnt vmcnt(0)" ::: "memory");
  __syncthreads();
  if (threadIdx.x == 0) {
    unsigned* bar = b.bar;
    __builtin_amdgcn_s_waitcnt(0);
    unsigned nloc = b.st[0], nx = b.st[1];
    if (nloc == 0u) { xcd_barrier_complete(bar, b.x, nloc, nx); b.st[0] = nloc; b.st[1] = nx; }
    const unsigned old = xb_add(&bar[XB_XSUB(b.x)], 1u);
    const unsigned gen = old / nloc;
    if (old + 1u == (gen + 1u) * nloc) {
      __builtin_amdgcn_fence(__ATOMIC_RELEASE, "agent");
      asm volatile("s_waitcnt vmcnt(0)" ::: "memory");
      const unsigned og = xb_add(&bar[XB_TOP], 1u);
      const unsigned tg = og / nx;
      if (og + 1u == (tg + 1u) * nx) xb_add(&bar[XB_TOPGEN], 1u);
      else XB_SPIN(xb_ld(&bar[XB_TOPGEN]) == tg, bar);
      __builtin_amdgcn_fence(__ATOMIC_ACQUIRE, "agent");
      xb_add(&bar[XB_XGEN(b.x)], 1u);
      asm volatile("s_waitcnt vmcnt(0)" ::: "memory");
    } else {
      XB_SPIN(xb_ld(&bar[XB_XGEN(b.x)]) == gen, bar);
      __builtin_amdgcn_fence(__ATOMIC_ACQUIRE, "agent");
      asm volatile("s_waitcnt vmcnt(0)" ::: "memory");
    }
  }
  __syncthreads();
}


namespace g8 {
constexpr int BK = 64, HALF = 128, HT = HALF * BK;
DI int lds_byte(int r, int c) { const int st = (r >> 4) * 2 + (c >> 5), rr = r & 15, cc = c & 31, ob = rr * 64 + cc * 2; return st * 1024 + (ob ^ (((ob >> 9) & 1) << 5)); }
DI void stage_rc(int b, int& R, int& C) { const int st = b / 1024, sb = b % 1024, swz = sb ^ (((sb >> 9) & 1) << 5); R = (st >> 1) * 16 + swz / 64; C = (st & 1) * 32 + (swz % 64) / 2; }
}

DI void gemm8_resid_epilogue(const GemmArgs& g, f32x4 (&acc)[2][2][4][2], const int brow, const int bcol, const int wr, const int wc, const int fr, const int fq) {
  float* X = (float*)g.out0;
  const float* src = g.src;
  const float sc = g.scale;
  auto base = [&](int ai, int bj) -> size_t { return (size_t)(brow + ai * 128 + wr * 64 + fr) * DM + bcol + bj * 128 + wc * 32 + fq * 4; };
  f32x4 ra[4][2], rb[4][2];
  auto ld = [&](f32x4 (&r)[4][2], size_t ib) {
#pragma unroll
    for (int m = 0; m < 4; ++m)
#pragma unroll
      for (int n = 0; n < 2; ++n) r[m][n] = *(const f32x4*)(src + ib + (size_t)(m * 16) * DM + n * 16);
  };
  auto st = [&](const f32x4 (&r)[4][2], const f32x4 (&a)[4][2], size_t ib) {
#pragma unroll
    for (int m = 0; m < 4; ++m)
#pragma unroll
      for (int n = 0; n < 2; ++n) {
        f32x4 o;
        o.x = r[m][n].x + sc * a[m][n][0]; o.y = r[m][n].y + sc * a[m][n][1];
        o.z = r[m][n].z + sc * a[m][n][2]; o.w = r[m][n].w + sc * a[m][n][3];
        *(f32x4*)(X + ib + (size_t)(m * 16) * DM + n * 16) = o;
      }
  };
  const size_t b00 = base(0, 0), b01 = base(0, 1), b10 = base(1, 0), b11 = base(1, 1);
  ld(ra, b00); ld(rb, b01);
  st(ra, acc[0][0], b00); ld(ra, b10);
  st(rb, acc[0][1], b01); ld(rb, b11);
  st(ra, acc[1][0], b10);
  st(rb, acc[1][1], b11);
}

template <int EPI>
DI void gemm8_epilogue(const GemmArgs& g, f32x4 (&acc)[2][2][4][2], const int brow, const int bcol, const int wr, const int wc, const int fr, const int fq) {
#pragma unroll
  for (int ai = 0; ai < 2; ++ai) {
#pragma unroll
    for (int bj = 0; bj < 2; ++bj) {
      const int cb = bcol + bj * 128 + wc * 32;
      const int r0 = brow + ai * 128 + wr * 64 + fr;
      if constexpr (EPI == EPI_SWIGLU) {
        bf16_t* H = (bf16_t*)g.out0;
        const int hc = (cb >> 1) + fq * 4;
#pragma unroll
        for (int m = 0; m < 4; ++m) {
          float v[4];
#pragma unroll
          for (int j = 0; j < 4; ++j) { const float gt = acc[ai][bj][m][0][j], up = acc[ai][bj][m][1][j]; v[j] = gt * up * __builtin_amdgcn_rcpf(1.f + __expf(-gt)); }
          u32x2 o; o.x = pack2(v[0], v[1]); o.y = pack2(v[2], v[3]);
          *(u32x2*)&H[(size_t)(r0 + m * 16) * DFF + hc] = o;
        }
      } else if constexpr (EPI == EPI_RESID) {
        float* X = (float*)g.out0;
        const float* __restrict__ src = g.src;
        const size_t ibase = (size_t)r0 * DM + cb + fq * 4;
        f32x4 rr[4][2];
#pragma unroll
        for (int m = 0; m < 4; ++m)
#pragma unroll
          for (int n = 0; n < 2; ++n) rr[m][n] = *(const f32x4*)(src + ibase + (size_t)(m * 16) * DM + n * 16);
#pragma unroll
        for (int m = 0; m < 4; ++m)
#pragma unroll
          for (int n = 0; n < 2; ++n) {
            f32x4 o;
            o.x = rr[m][n].x + g.scale * acc[ai][bj][m][n][0]; o.y = rr[m][n].y + g.scale * acc[ai][bj][m][n][1];
            o.z = rr[m][n].z + g.scale * acc[ai][bj][m][n][2]; o.w = rr[m][n].w + g.scale * acc[ai][bj][m][n][3];
            *(f32x4*)(X + ibase + (size_t)(m * 16) * DM + n * 16) = o;
          }
      } else if constexpr (EPI == EPI_PROJ_EVEN) {
        if ((bcol == 2304 || bcol == 2560) && bj == 1) {
          bf16_t* VT = (bf16_t*)(bcol == 2304 ? g.out1 : g.out2);
#pragma unroll
          for (int m = 0; m < 4; ++m) {
            const int row = r0 + m * 16, b = row >> 12, t = row & 4095;
#pragma unroll
            for (int n = 0; n < 2; ++n)
#pragma unroll
              for (int j = 0; j < 4; ++j) {
                const int d = wc * 32 + n * 16 + fq * 4 + j;
                VT[((size_t)((b * 2 + (d >> 6)) * 64 + (d & 63))) * SEQ + t] = f2bf(acc[ai][bj][m][n][j]);
              }
          }
        } else {
          bf16_t* P = (bf16_t*)g.out0;
#pragma unroll
          for (int n = 0; n < 2; ++n) {
            const int col = cb + n * 16 + fq * 4;
            if (col < 2840) {
#pragma unroll
              for (int m = 0; m < 4; ++m) {
                u32x2 o; o.x = pack2(acc[ai][bj][m][n][0], acc[ai][bj][m][n][1]); o.y = pack2(acc[ai][bj][m][n][2], acc[ai][bj][m][n][3]);
                *(u32x2*)&P[(size_t)(r0 + m * 16) * LDP_E + col] = o;
              }
            }
          }
        }
      } else {
        if (bcol >= 2048) {
          bf16_t* VT = (bf16_t*)g.out1;
#pragma unroll
          for (int m = 0; m < 4; ++m) {
            const int row = r0 + m * 16, b = row >> 12, t = row & 4095;
#pragma unroll
            for (int n = 0; n < 2; ++n)
#pragma unroll
              for (int j = 0; j < 4; ++j) {
                const int c = cb - 2048 + n * 16 + fq * 4 + j;
                VT[((size_t)((b * 16 + (c >> 6)) * 64 + (c & 63))) * SEQ + t] = f2bf(acc[ai][bj][m][n][j]);
              }
          }
        } else {
          bf16_t* P = (bf16_t*)g.out0;
#pragma unroll
          for (int n = 0; n < 2; ++n) {
            const int col = cb + n * 16 + fq * 4;
#pragma unroll
            for (int m = 0; m < 4; ++m) {
              u32x2 o; o.x = pack2(acc[ai][bj][m][n][0], acc[ai][bj][m][n][1]); o.y = pack2(acc[ai][bj][m][n][2], acc[ai][bj][m][n][3]);
              *(u32x2*)&P[(size_t)(r0 + m * 16) * LDP_O + col] = o;
            }
          }
        }
      }
    }
  }
}

template <int EPI, bool ALIGN_EPI = true, bool SP2 = true>
DI void gemm8_phase(const GemmArgs& g, char* lds_) {
  using namespace g8;
  LAS unsigned char* lds = (LAS unsigned char*)lds_;
  const int tid = otid();
  const int wid = __builtin_amdgcn_readfirstlane(tid >> 6), lane = tid & 63, wr = wid >> 2, wc = wid & 3, fr = lane & 15, fq = lane >> 4;
  constexpr bool TRANSPOSED = true;
  constexpr int EPI_VM = 0;
  const int K = g.K, nt = K / BK;
  const int total = g.NTm * g.NTn, G = gridDim.x;
  if ((int)blockIdx.x >= total) return;
  unsigned voff[2];
#pragma unroll
  for (int i = 0; i < 2; ++i) { int R, C; stage_rc(tid * 16 + i * 8192, R, C); voff[i] = (unsigned)(R * K + C) * 2u; }
  const size_t kstep = (size_t)(BK * 2);
  const size_t hstep = (size_t)HALF * K * 2;
  const size_t tstep = 2 * hstep;
  const unsigned ldsw = (unsigned)wid * 1024u;
  const int aoff = lds_byte(wr * 64 + fr, fq * 8), boff = lds_byte(wc * 32 + fr, fq * 8);
  constexpr int HTB = HT * 2;
#define PG8_SA(b, h) (((b) * 2 + (h)) * HTB)
#define PG8_SB(b, h) ((4 + (b) * 2 + (h)) * HTB)
#define PG8_STAGE(bufoff, gbase) do { _Pragma("unroll") for (int _i = 0; _i < 2; ++_i) \
    __builtin_amdgcn_global_load_lds((const unsigned*)((const char*)(gbase) + voff[_i]), (LAS unsigned*)(lds + (bufoff) + ldsw + _i * 8192), 16, 0, 0); } while (0)
#define PG8_LDA(dst, b, h) do { _Pragma("unroll") for (int m = 0; m < 4; ++m) _Pragma("unroll") for (int k = 0; k < 2; ++k) dst[m][k] = *(const LAS bf16x8*)(lds + PG8_SA(b, h) + aoff + m * 2048 + k * 1024); } while (0)
#define PG8_LDB(dst, b, h) do { _Pragma("unroll") for (int n = 0; n < 2; ++n) _Pragma("unroll") for (int k = 0; k < 2; ++k) dst[n][k] = *(const LAS bf16x8*)(lds + PG8_SB(b, h) + boff + n * 2048 + k * 1024); } while (0)
#define PG8_MMA(ai, bj, At_, Bt_) do { __builtin_amdgcn_s_setprio(1); _Pragma("unroll") for (int m = 0; m < 4; ++m) _Pragma("unroll") for (int n = 0; n < 2; ++n) _Pragma("unroll") for (int k = 0; k < 2; ++k) \
    acc[ai][bj][m][n] = TRANSPOSED ? __builtin_amdgcn_mfma_f32_16x16x32_bf16(Bt_[n][k], At_[m][k], acc[ai][bj][m][n], 0, 0, 0) \
                                   : __builtin_amdgcn_mfma_f32_16x16x32_bf16(At_[m][k], Bt_[n][k], acc[ai][bj][m][n], 0, 0, 0); __builtin_amdgcn_s_setprio(0); } while (0)
#define PG8_WAIT_V(n) asm volatile("s_waitcnt vmcnt(" #n ")" ::: "memory")
#define PG8_WAIT_L(n) asm volatile("s_waitcnt lgkmcnt(" #n ")" ::: "memory")
#define PG8_BAR __builtin_amdgcn_s_barrier()
#define PG8_SCHED __builtin_amdgcn_sched_barrier(0)
  int ui = 0, cpm, cpn, npm = 0, npn = 0;
  tile_map(blockIdx.x, g.NTm, g.NTn, cpm, cpn, g.gm);
  f32x4 acc[2][2][4][2];
#pragma unroll
  for (int a = 0; a < 2; ++a)
#pragma unroll
    for (int b = 0; b < 2; ++b)
#pragma unroll
      for (int m = 0; m < 4; ++m)
#pragma unroll
        for (int n = 0; n < 2; ++n) acc[a][b][m][n] = f32x4{0.f, 0.f, 0.f, 0.f};
  bf16x8 At[4][2], B0[2][2], B1[2][2];
  const char* cA = (const char*)g.A0 + (size_t)cpm * tstep;
  const char* cB = (const char*)g.Bt0 + (size_t)cpn * tstep;
  PG8_WAIT_V(0);
  __syncthreads();
  if constexpr (SP2) {
    PG8_STAGE(PG8_SB(0, 0), cB); PG8_STAGE(PG8_SB(0, 1), cB + hstep); PG8_STAGE(PG8_SA(0, 0), cA); PG8_STAGE(PG8_SA(0, 1), cA + hstep);
    if (wr == 1) PG8_BAR;
    PG8_WAIT_V(2); PG8_BAR;
    PG8_STAGE(PG8_SB(1, 0), cB + kstep); PG8_STAGE(PG8_SA(1, 0), cA + kstep); PG8_STAGE(PG8_SB(1, 1), cB + hstep + kstep);
    PG8_WAIT_V(6); PG8_BAR;
  } else {
    PG8_STAGE(PG8_SB(0, 0), cB); PG8_STAGE(PG8_SA(0, 0), cA); PG8_STAGE(PG8_SB(0, 1), cB + hstep); PG8_STAGE(PG8_SA(0, 1), cA + hstep);
    if (wr == 1) PG8_BAR;
    PG8_WAIT_V(4); PG8_BAR;
    PG8_STAGE(PG8_SB(1, 0), cB + kstep); PG8_STAGE(PG8_SA(1, 0), cA + kstep); PG8_STAGE(PG8_SB(1, 1), cB + hstep + kstep);
    PG8_WAIT_V(6); PG8_BAR;
  }
  for (;;) {
    const int nid = (int)blockIdx.x + (ui + 1) * G;
    const bool has_next = nid < total;
    if (has_next) tile_map(nid, g.NTm, g.NTn, npm, npn, g.gm);
    const char* nA = has_next ? (const char*)g.A0 + (size_t)npm * tstep : cA;
    const char* nB = has_next ? (const char*)g.Bt0 + (size_t)npn * tstep : cB;
#pragma unroll 1
    for (int t = 0; t < nt; t += 2) {
      const bool last = (t == nt - 2);
      const char* a1 = cA + (size_t)(t + 1) * kstep;
      const char* a2 = last ? nA : cA + (size_t)(t + 2) * kstep;
      const char* b2 = last ? nB : cB + (size_t)(t + 2) * kstep;
      const char* a3 = a2 + kstep; const char* b3 = b2 + kstep;
      if constexpr (SP2) {
        const bool relax = EPI_VM > 0 && t == 0 && ui > 0;
        PG8_LDB(B0, 0, 0); PG8_LDB(B1, 0, 1); PG8_SCHED; PG8_LDA(At, 0, 0); PG8_STAGE(PG8_SA(1, 1), a1 + hstep);
        if (relax) PG8_WAIT_V(24); else PG8_WAIT_V(8);
        PG8_WAIT_L(0); PG8_BAR; PG8_MMA(0, 0, At, B0); PG8_MMA(0, 1, At, B1); PG8_BAR; PG8_SCHED;
        PG8_LDA(At, 0, 1); PG8_STAGE(PG8_SB(0, 0), b2); PG8_STAGE(PG8_SB(0, 1), b2 + hstep); PG8_STAGE(PG8_SA(0, 0), a2);
        if (relax) PG8_WAIT_V(24); else PG8_WAIT_V(8);
        PG8_WAIT_L(0); PG8_BAR; PG8_MMA(1, 0, At, B0); PG8_MMA(1, 1, At, B1); PG8_BAR; PG8_SCHED;
        PG8_LDB(B0, 1, 0); PG8_LDB(B1, 1, 1); PG8_SCHED; PG8_LDA(At, 1, 0); PG8_STAGE(PG8_SA(0, 1), a2 + hstep);
        PG8_WAIT_V(8); PG8_WAIT_L(0); PG8_BAR; PG8_MMA(0, 0, At, B0); PG8_MMA(0, 1, At, B1); PG8_BAR; PG8_SCHED;
        PG8_LDA(At, 1, 1); PG8_STAGE(PG8_SB(1, 0), b3); PG8_STAGE(PG8_SB(1, 1), b3 + hstep); PG8_STAGE(PG8_SA(1, 0), a3);
        PG8_WAIT_V(8); PG8_WAIT_L(0); PG8_BAR; PG8_MMA(1, 0, At, B0); PG8_MMA(1, 1, At, B1); PG8_BAR; PG8_SCHED;
      } else {
        PG8_LDB(B0, 0, 0); PG8_SCHED; PG8_LDA(At, 0, 0); PG8_STAGE(PG8_SA(1, 1), a1 + hstep);
        PG8_WAIT_L(8); PG8_BAR; PG8_WAIT_L(0); PG8_MMA(0, 0, At, B0); PG8_BAR; PG8_SCHED;
        PG8_LDB(B1, 0, 1); PG8_STAGE(PG8_SB(0, 0), b2);
        PG8_BAR; PG8_WAIT_L(0); PG8_MMA(0, 1, At, B1); PG8_BAR;
        PG8_LDA(At, 0, 1); PG8_STAGE(PG8_SA(0, 0), a2);
        PG8_BAR; PG8_WAIT_L(0); PG8_MMA(1, 0, At, B0); PG8_BAR; PG8_SCHED;
        PG8_STAGE(PG8_SB(0, 1), b2 + hstep);
        PG8_WAIT_V(6); PG8_BAR; PG8_MMA(1, 1, At, B1); PG8_BAR;
        PG8_LDB(B0, 1, 0); PG8_SCHED; PG8_LDA(At, 1, 0); PG8_STAGE(PG8_SA(0, 1), a2 + hstep);
        PG8_WAIT_L(8); PG8_BAR; PG8_WAIT_L(0); PG8_MMA(0, 0, At, B0); PG8_BAR; PG8_SCHED;
        PG8_LDB(B1, 1, 1); PG8_STAGE(PG8_SB(1, 0), b3);
        PG8_BAR; PG8_WAIT_L(0); PG8_MMA(0, 1, At, B1); PG8_BAR;
        PG8_LDA(At, 1, 1); PG8_STAGE(PG8_SA(1, 0), a3);
        PG8_BAR; PG8_WAIT_L(0); PG8_MMA(1, 0, At, B0); PG8_BAR; PG8_SCHED;
        PG8_STAGE(PG8_SB(1, 1), b3 + hstep);
        PG8_WAIT_V(6); PG8_BAR; PG8_MMA(1, 1, At, B1); PG8_BAR;
      }
    }
    if constexpr (ALIGN_EPI) { if (wr == 0) PG8_BAR; }
    if constexpr (EPI == EPI_RESID) gemm8_resid_epilogue(g, acc, cpm * 256, cpn * 256, wr, wc, fr, fq);
    else gemm8_epilogue<EPI>(g, acc, cpm * 256, cpn * 256, wr, wc, fr, fq);
    if (!has_next) break;
#pragma unroll
    for (int a = 0; a < 2; ++a)
#pragma unroll
      for (int b = 0; b < 2; ++b)
#pragma unroll
        for (int m = 0; m < 4; ++m)
#pragma unroll
          for (int n = 0; n < 2; ++n) acc[a][b][m][n] = f32x4{0.f, 0.f, 0.f, 0.f};
    cpm = npm; cpn = npn; cA = nA; cB = nB; ++ui;
    if constexpr (ALIGN_EPI) { if (wr == 1) PG8_BAR; }
  }
  PG8_WAIT_V(0);
  if constexpr (!ALIGN_EPI) { if (wr == 0) PG8_BAR; }
  PG8_BAR;
#undef PG8_SA
#undef PG8_SB
#undef PG8_STAGE
#undef PG8_LDA
#undef PG8_LDB
#undef PG8_MMA
#undef PG8_WAIT_V
#undef PG8_WAIT_L
#undef PG8_BAR
#undef PG8_SCHED
}

#define PH_BEGIN if (ph >= p.ph_lo && ph < p.ph_hi) {
#define PH_END   if (ph + 1 < p.ph_hi) { if (p.ph_hi < 0) grid.sync(); else xcd_barrier(xb); } } ++ph;

__global__ void __launch_bounds__(512, 2) fwd_megakernel(Params p) {
  __shared__ __attribute__((aligned(16))) char lds[LDS_BYTES + 64];
  cg::grid_group grid = cg::this_grid();
  unsigned char* ws = p.ws;
  if (threadIdx.x < 16) ((unsigned*)(lds + LDS_BYTES))[threadIdx.x] = 0u;
  __syncthreads();
  XcdBarrier xb = xcd_barrier_post((unsigned*)(ws + OFF_BAR), (volatile LAS unsigned*)(LAS char*)(lds + LDS_BYTES));
  bf16_t* XB = (bf16_t*)(ws + OFF_XB);
  bf16_t* Yb = (bf16_t*)(ws + OFF_Y);
  bf16_t* R = (bf16_t*)(ws + OFF_R);
  float* X = p.X;
  int ph = 0;

  PH_BEGIN
    prep_phase(p, lds);
    rownorm_phase(p.in[0], XB);
  PH_END

#pragma unroll 1
  for (int step = 0; step < 12; ++step) {
    const int l = step / 3, s = step - 3 * l;
    GemmArgs ra{};
    ra.NTm = 128; ra.NTn = 4; ra.nmat = 1; ra.gm = 4; ra.out0 = X; ra.src = (step == 0) ? p.in[0] : X;
    if (s != 1) {
      const int f = s >> 1;
      PH_BEGIN
        GemmArgs ga{};
        ga.A0 = XB; ga.lda = DM; ga.Bt0 = w_ffn_in(ws, l, f); ga.K = DM; ga.NTm = 128; ga.NTn = 22; ga.nmat = 1; ga.gm = 4; ga.out0 = R;
        gemm8_phase<EPI_SWIGLU>(ga, lds);
      PH_END
      ra.A0 = R; ra.lda = DFF; ra.K = DFF; ra.Bt0 = w_ffn_out(ws, l, f); ra.scale = 0.5f; ra.gm = 2;
    } else if ((l & 1) == 0) {
      const int i = l >> 1;
      bf16_t* VTS = (bf16_t*)(ws + OFF_VTS);
      bf16_t* VTW = (bf16_t*)(ws + OFF_VTW);
      bf16_t* HC = (bf16_t*)(ws + OFF_HC);
      bf16_t* KC = (bf16_t*)(ws + OFF_KC);
      bf16_t* VCT = (bf16_t*)(ws + OFF_VCT);
      PH_BEGIN
        GemmArgs ga{};
        ga.A0 = XB; ga.lda = DM; ga.Bt0 = w_ab(ws, i); ga.K = DM; ga.NTm = 128; ga.NTn = 12; ga.nmat = 1; ga.gm = 4;
        ga.out0 = R; ga.out1 = VTS; ga.out2 = VTW;
        gemm8_phase<EPI_PROJ_EVEN>(ga, lds);
      PH_END
      PH_BEGIN
        GemmArgs ga{};
        ga.A0 = R; ga.A1 = R; ga.aoff0 = 2048; ga.aoff1 = 2176; ga.Bt0 = w_c1(ws, i, 0); ga.Bt1 = w_c1(ws, i, 1);
        ga.K = 2048; ga.NTm = 32; ga.NTn = 1; ga.nmat = 2; ga.out0 = HC; ga.out1 = HC + 4096 * 128;
        ga.bias0 = (const float*)(ws + OFF_BIAS) + (i * 2 + 0) * 128; ga.bias1 = (const float*)(ws + OFF_BIAS) + (i * 2 + 1) * 128;
        const float* cw = p.in[6] + (size_t)i * 3 * 512;
        const int hf = otid() >> 8;
        for (int id = blockIdx.x; id < 64 + 512; id += gridDim.x) {
          if (id < 64) {
            const int kv = id >> 5; int mt, nt; tile_map(id & 31, 32, 1, mt, nt);
            gemm_tile<EPI_CMP1>(ga, kv, mt, nt, lds + hf * GEMM_LDS, hf * 16, hf * 16 + 16, (float*)(lds + GEMM_LDS), hf);
          } else {
            conv_item(R, cw, Yb, (id - 64) * 2 + hf);
          }
        }
      PH_END
      PH_BEGIN
        GemmArgs ga{};
        ga.A0 = HC; ga.A1 = HC + 4096 * 128; ga.lda = 128; ga.Bt0 = w_c2(ws, i, 0); ga.Bt1 = w_c2(ws, i, 1);
        ga.K = 128; ga.NTm = 32; ga.NTn = 1; ga.nmat = 2; ga.out0 = KC; ga.out1 = VCT;
        gemm_pair_phase<EPI_CMP2>(ga, lds);
      PH_END
      PH_BEGIN
        for (int it = blockIdx.x; it < 1024; it += gridDim.x) nsa_item(R, KC, VCT, VTS, VTW, Yb, it, lds);
      PH_END
      ra.A0 = Yb; ra.lda = DM; ra.K = DM; ra.Bt0 = w_abo(ws, i); ra.scale = 1.f;
    } else {
      const int i = l >> 1;
      bf16_t* VTO = (bf16_t*)(ws + OFF_VTO);
      PH_BEGIN
        GemmArgs ga{};
        ga.A0 = XB; ga.lda = DM; ga.Bt0 = w_qkv(ws, i); ga.K = DM; ga.NTm = 128; ga.NTn = 12; ga.nmat = 1; ga.gm = 4;
        ga.out0 = R; ga.out1 = VTO;
        gemm8_phase<EPI_PROJ_ODD>(ga, lds);
      PH_END
      PH_BEGIN
        for (int it = blockIdx.x; it < 2048; it += gridDim.x) sb_item(R, VTO, Yb, it, lds);
      PH_END
      ra.A0 = Yb; ra.lda = DM; ra.K = DM; ra.Bt0 = w_sbo(ws, i); ra.scale = 1.f;
    }
    PH_BEGIN
      gemm8_phase<EPI_RESID, false>(ra, lds);
    PH_END
    PH_BEGIN
      if (step < 11) rownorm_phase(X, XB);
      else finalnorm_phase(X, p.in[19]);
    PH_END
  }
}

extern "C" void kernel_launch(void* const* d_in, const int* in_sizes, int n_in, void* d_out, int out_size, void* d_ws, size_t ws_size,
                              hipStream_t stream) {
  static int grid_blocks = 0;
  if (!grid_blocks) {
    int dev = 0, cus = 0, per_cu = 0;
    (void)hipGetDevice(&dev);
    (void)hipDeviceGetAttribute(&cus, hipDeviceAttributeMultiprocessorCount, dev);
    (void)hipOccupancyMaxActiveBlocksPerMultiprocessor(&per_cu, fwd_megakernel, 512, 0);
    if (per_cu != 1) fprintf(stderr, "kernel_launch: occupancy query says %d blocks/CU; launching 1 per CU\n", per_cu);
    grid_blocks = cus;
    if (ws_size < WS_END) fprintf(stderr, "kernel_launch: workspace too small: %zu < %zu\n", ws_size, (size_t)WS_END);
    if (n_in != 20 || out_size != NT * DM) fprintf(stderr, "kernel_launch: unexpected shapes n_in=%d out=%d\n", n_in, out_size);
  }
  (void)hipMemsetAsync((char*)d_ws + OFF_BAR, 0, XCD_BAR_WORDS * 4, stream);
  Params p{};
  for (int i = 0; i < 20; ++i) p.in[i] = (const float*)d_in[i];
  p.X = (float*)d_out;
  p.ws = (unsigned char*)d_ws;
  p.ph_lo = 0; p.ph_hi = 1 << 20;
  void* args[] = {&p};
  hipError_t e = hipLaunchCooperativeKernel((void*)fwd_megakernel, dim3(grid_blocks), dim3(512), args, 0, stream);
  if (e != hipSuccess) fprintf(stderr, "cooperative launch failed: %s (grid %d)\n", hipGetErrorString(e), grid_blocks);
}
```

```cpp
#include <hip/hip_runtime.h>
#include <hip/hip_cooperative_groups.h>
#include <cstdio>
#include <cstdint>
namespace cg = cooperative_groups;

typedef unsigned short bf16_t;
typedef short bf16x8 __attribute__((ext_vector_type(8)));
typedef float f32x16 __attribute__((ext_vector_type(16)));
typedef float f32x4 __attribute__((ext_vector_type(4)));
typedef unsigned u32x4 __attribute__((ext_vector_type(4)));
typedef unsigned u32x2 __attribute__((ext_vector_type(2)));
typedef unsigned long long u64;

#define DI __device__ __forceinline__
#define MFMA32(a, b, c) __builtin_amdgcn_mfma_f32_32x32x16_bf16((a), (b), (c), 0, 0, 0)

#ifndef MK_PER_PHASE
#define MK_PER_PHASE 0
#endif

constexpr int NT = 32768, DM = 1024, DFF = 2816, SEQ = 4096;
constexpr int LDP_E = 2944, LDP_O = 2048;
constexpr int NPHASES = 45;

constexpr size_t OFF_XB = 0;
constexpr size_t OFF_Y = OFF_XB + (size_t)NT * DM * 2;
constexpr size_t OFF_R = OFF_Y + (size_t)NT * DM * 2;
constexpr size_t SZ_R = (size_t)NT * 3072 * 2;
constexpr size_t OFF_VTO = OFF_R + (size_t)NT * LDP_O * 2;
constexpr size_t OFF_VTS = OFF_R + SZ_R;
constexpr size_t OFF_VTW = OFF_VTS + (size_t)8 * 2 * 64 * 4096 * 2;
constexpr size_t OFF_HC = OFF_VTW + (size_t)8 * 2 * 64 * 4096 * 2;
constexpr size_t OFF_KC = OFF_HC + (size_t)2 * 4096 * 128 * 2;
constexpr size_t OFF_VCT = OFF_KC + (size_t)4096 * 64 * 2;
constexpr size_t OFF_BIAS = OFF_VCT + (size_t)4096 * 64 * 2;
constexpr size_t OFF_W = OFF_BIAS + 4096;
constexpr size_t E_FIN = (size_t)5632 * 1024, E_FOUT = (size_t)1024 * 2816, E_FFN = E_FIN + E_FOUT;
constexpr size_t E_AB = (size_t)3072 * 1024, E_ABO = (size_t)1024 * 1024, E_W1 = (size_t)128 * 2048, E_W2 = (size_t)128 * 128;
constexpr size_t E_EVEN = E_AB + E_ABO + 2 * E_W1 + 2 * E_W2;
constexpr size_t E_QKV = (size_t)3072 * 1024, E_ODD = E_QKV + E_ABO;
constexpr size_t OFF_WFFN = OFF_W;
constexpr size_t OFF_WEVEN = OFF_WFFN + 8 * E_FFN * 2;
constexpr size_t OFF_WODD = OFF_WEVEN + 2 * E_EVEN * 2;
constexpr size_t OFF_BAR = OFF_WODD + 2 * E_ODD * 2;
constexpr size_t WS_END = OFF_BAR + 16384;

struct Params {
  const float* in[20];
  float* X;
  unsigned char* ws;
  int ph_lo, ph_hi;
};

DI bf16_t f2bf(float x) { unsigned u = __float_as_uint(x); u += 0x7fffu + ((u >> 16) & 1u); return (bf16_t)(u >> 16); }
DI float bf2f(bf16_t v) { return __uint_as_float(((unsigned)v) << 16); }
typedef __bf16 hwbf16x2 __attribute__((ext_vector_type(2)));
typedef float f32x2 __attribute__((ext_vector_type(2)));
DI unsigned pack2(float a, float b) { f32x2 v = {a, b}; return __builtin_bit_cast(unsigned, __builtin_convertvector(v, hwbf16x2)); }
DI float bflo(unsigned u) { return __uint_as_float(u << 16); }
DI float bfhi(unsigned u) { return __uint_as_float(u & 0xffff0000u); }
DI float wave_sum(float v) {
#pragma unroll
  for (int o = 1; o < 64; o <<= 1) v += __shfl_xor(v, o);
  return v;
}
DI int otid() { int t = threadIdx.x; asm volatile("" : "+v"(t)); return t; }
DI void half_swap(float x, float& r0, float& r1) {
  const auto r = __builtin_amdgcn_permlane32_swap(__float_as_uint(x), __float_as_uint(x), false, false);
  r0 = __uint_as_float(r[0]); r1 = __uint_as_float(r[1]);
}
DI float half_max(float x) { float a, b; half_swap(x, a, b); return fmaxf(a, b); }
DI float half_sum(float x) { float a, b; half_swap(x, a, b); return a + b; }
DI float half_other(float x, int hh) { float a, b; half_swap(x, a, b); return hh ? a : b; }
DI int crow(int reg, int hh) { return (reg & 3) + 8 * (reg >> 2) + 4 * hh; }
DI float sigmoidf(float x) { return 1.f / (1.f + __expf(-x)); }
DI float gelu_tanh(float x) {
  float u = 0.7978845608028654f * (x + 0.044715f * x * x * x);
  float t = 1.f - 2.f / (1.f + __expf(2.f * u));
  return 0.5f * x * (1.f + t);
}

enum { EPI_SWIGLU = 0, EPI_RESID = 1, EPI_PROJ_EVEN = 2, EPI_PROJ_ODD = 3, EPI_CMP1 = 4, EPI_CMP2 = 5 };

struct GemmArgs {
  const bf16_t* A0; const bf16_t* A1; int lda; int aoff0, aoff1;
  const bf16_t* Bt0; const bf16_t* Bt1;
  int K, NTm, NTn, nmat, gm;
  void* out0; void* out1; void* out2;
  const float* src; float scale;
  const float* bias0; const float* bias1;
};

DI void tile_map(int id, int NTm, int NTn, int& mt, int& nt, int gm = 4) {
  const int x = id & 7, j = id >> 3;
  const int MX = NTm >> 3;
  const int GM = MX < gm ? MX : gm;
  const int per = GM * NTn;
  const int mg = j / per, r = j - mg * per;
  nt = r / GM;
  const int mi = r - nt * GM;
  mt = x * MX + mg * GM + mi;
}

constexpr int LDT = 72;
constexpr int GEMM_LDS = 2 * 2 * 128 * LDT * 2;
constexpr int LDS_BYTES = 2 * GEMM_LDS;

template <int EPI>
DI void gemm_tile(const GemmArgs& g, const int kv, const int mt, const int nt, char* lds, const int kt0 = 0, int kt1 = -1, float* red = nullptr, const int hfid = 0) {
  const int tid = otid() & 255, lane = tid & 63, wave = tid >> 6;
  const int wm = wave >> 1, wn = wave & 1, l32 = lane & 31, hh = lane >> 5;
  bf16_t* As = (bf16_t*)lds;
  bf16_t* Bs = As + 2 * 128 * LDT;
  const int m0 = mt * 128, n0 = nt * 128;
  const int K = g.K, nk = kt1 < 0 ? (K >> 6) : kt1;
  const int lr = tid >> 3, lc = (tid & 7) * 8;
  const bf16_t* Abase = kv ? g.A1 : g.A0;
  const int aoff = kv ? g.aoff1 : g.aoff0;
  const bf16_t* Bbase = (kv ? g.Bt1 : g.Bt0) + (size_t)(n0 + lr) * K + lc;

  auto aaddr = [&](int i, int kt) -> const bf16_t* {
    const int r = m0 + lr + 32 * i;
    if constexpr (EPI == EPI_CMP1) {
      const int bg = r >> 8; int n = r & 255; n = n > 254 ? 254 : n;
      const size_t tok = (size_t)(bg >> 1) * SEQ + 16 * n + kt;
      return Abase + tok * LDP_E + aoff + (bg & 1) * 64 + lc;
    } else {
      return Abase + (size_t)r * g.lda + kt * 64 + lc;
    }
  };

  f32x16 acc[2][2];
#pragma unroll
  for (int i = 0; i < 2; ++i)
#pragma unroll
    for (int j = 0; j < 2; ++j)
#pragma unroll
      for (int e = 0; e < 16; ++e) acc[i][j][e] = 0.f;

  u32x4 ra[4], rb[4];
#pragma unroll
  for (int i = 0; i < 4; ++i) { ra[i] = *(const u32x4*)aaddr(i, kt0); rb[i] = *(const u32x4*)(Bbase + (size_t)(32 * i) * K + kt0 * 64); }
#pragma unroll
  for (int i = 0; i < 4; ++i) { *(u32x4*)&As[(lr + 32 * i) * LDT + lc] = ra[i]; *(u32x4*)&Bs[(lr + 32 * i) * LDT + lc] = rb[i]; }
  __syncthreads();

  for (int kt = kt0; kt < nk; ++kt) {
    const int cur = (kt - kt0) & 1;
    if (kt + 1 < nk) {
#pragma unroll
      for (int i = 0; i < 4; ++i) { ra[i] = *(const u32x4*)aaddr(i, kt + 1); rb[i] = *(const u32x4*)(Bbase + (size_t)(32 * i) * K + (kt + 1) * 64); }
    }
    const bf16_t* as = As + cur * 128 * LDT + (wm * 64 + l32) * LDT + hh * 8;
    const bf16_t* bs = Bs + cur * 128 * LDT + (wn * 64 + l32) * LDT + hh * 8;
#pragma unroll
    for (int ks = 0; ks < 4; ++ks) {
      const bf16x8 a0 = *(const bf16x8*)(as + ks * 16);
      const bf16x8 a1 = *(const bf16x8*)(as + 32 * LDT + ks * 16);
      const bf16x8 b0 = *(const bf16x8*)(bs + ks * 16);
      const bf16x8 b1 = *(const bf16x8*)(bs + 32 * LDT + ks * 16);
      acc[0][0] = MFMA32(a0, b0, acc[0][0]);
      acc[0][1] = MFMA32(a0, b1, acc[0][1]);
      acc[1][0] = MFMA32(a1, b0, acc[1][0]);
      acc[1][1] = MFMA32(a1, b1, acc[1][1]);
    }
    if (kt + 1 < nk) {
      bf16_t* ad = As + (cur ^ 1) * 128 * LDT;
      bf16_t* bd = Bs + (cur ^ 1) * 128 * LDT;
#pragma unroll
      for (int i = 0; i < 4; ++i) { *(u32x4*)&ad[(lr + 32 * i) * LDT + lc] = ra[i]; *(u32x4*)&bd[(lr + 32 * i) * LDT + lc] = rb[i]; }
    }
    __syncthreads();
  }
  if (red) {
    if (hfid == 1) {
#pragma unroll
      for (int i = 0; i < 2; ++i)
#pragma unroll
        for (int j = 0; j < 2; ++j)
#pragma unroll
          for (int e = 0; e < 16; ++e) red[((i * 2 + j) * 16 + e) * 256 + tid] = acc[i][j][e];
    }
    __syncthreads();
    if (hfid == 0) {
#pragma unroll
      for (int i = 0; i < 2; ++i)
#pragma unroll
        for (int j = 0; j < 2; ++j)
#pragma unroll
          for (int e = 0; e < 16; ++e) acc[i][j][e] += red[((i * 2 + j) * 16 + e) * 256 + tid];
    }
    __syncthreads();
    if (hfid == 1) return;
  }

#pragma unroll
  for (int i = 0; i < 2; ++i) {
    const int rbase = m0 + wm * 64 + i * 32 + 4 * hh;
    if constexpr (EPI == EPI_SWIGLU) {
      bf16_t* H = (bf16_t*)g.out0;
      const int hc = ((n0 + wn * 64) >> 1) + l32;
#pragma unroll
      for (int e = 0; e < 16; ++e) {
        const int row = rbase + (e & 3) + 8 * (e >> 2);
        const float gt = acc[i][0][e], up = acc[i][1][e];
        H[(size_t)row * DFF + hc] = f2bf(gt / (1.f + __expf(-gt)) * up);
      }
    } else if constexpr (EPI == EPI_RESID) {
      float* X = (float*)g.out0;
      const float* __restrict__ src = g.src;
      const size_t ibase = (size_t)rbase * DM + n0 + wn * 64 + l32;
#pragma unroll
      for (int j = 0; j < 2; ++j)
#pragma unroll
        for (int e = 0; e < 16; ++e) {
          const float r = __builtin_nontemporal_load(src + ibase + (size_t)((e & 3) + 8 * (e >> 2)) * DM + j * 32);
          acc[i][j][e] = r + g.scale * acc[i][j][e];
        }
#pragma unroll
      for (int j = 0; j < 2; ++j)
#pragma unroll
        for (int e = 0; e < 16; ++e) X[ibase + (size_t)((e & 3) + 8 * (e >> 2)) * DM + j * 32] = acc[i][j][e];
    } else if constexpr (EPI == EPI_PROJ_EVEN) {
      if (n0 == 2432 || n0 == 2688) {
        bf16_t* VT = (bf16_t*)(n0 == 2432 ? g.out1 : g.out2);
#pragma unroll
        for (int j = 0; j < 2; ++j) {
          const int d = j * 32 + l32;
#pragma unroll
          for (int q4 = 0; q4 < 4; ++q4) {
            const int row = rbase + 8 * q4, b = row >> 12, t = row & 4095;
            u32x2 v; v.x = pack2(acc[i][j][4 * q4], acc[i][j][4 * q4 + 1]); v.y = pack2(acc[i][j][4 * q4 + 2], acc[i][j][4 * q4 + 3]);
            *(u32x2*)&VT[((size_t)((b * 2 + wn) * 64 + d)) * SEQ + t] = v;
          }
        }
      } else {
        bf16_t* P = (bf16_t*)g.out0;
#pragma unroll
        for (int j = 0; j < 2; ++j) {
          const int col = n0 + wn * 64 + j * 32 + l32;
          if (col < 2840) {
#pragma unroll
            for (int e = 0; e < 16; ++e) P[(size_t)(rbase + (e & 3) + 8 * (e >> 2)) * LDP_E + col] = f2bf(acc[i][j][e]);
          }
        }
      }
    } else if constexpr (EPI == EPI_PROJ_ODD) {
      if (n0 >= 2048) {
        bf16_t* VT = (bf16_t*)g.out1;
        const int hd = ((n0 - 2048) >> 6) + wn;
#pragma unroll
        for (int j = 0; j < 2; ++j) {
          const int d = j * 32 + l32;
#pragma unroll
          for (int q4 = 0; q4 < 4; ++q4) {
            const int row = rbase + 8 * q4, b = row >> 12, t = row & 4095;
            u32x2 v; v.x = pack2(acc[i][j][4 * q4], acc[i][j][4 * q4 + 1]); v.y = pack2(acc[i][j][4 * q4 + 2], acc[i][j][4 * q4 + 3]);
            *(u32x2*)&VT[((size_t)((b * 16 + hd) * 64 + d)) * SEQ + t] = v;
          }
        }
      } else {
        bf16_t* P = (bf16_t*)g.out0;
#pragma unroll
        for (int j = 0; j < 2; ++j) {
          const int col = n0 + wn * 64 + j * 32 + l32;
#pragma unroll
          for (int e = 0; e < 16; ++e) P[(size_t)(rbase + (e & 3) + 8 * (e >> 2)) * LDP_O + col] = f2bf(acc[i][j][e]);
        }
      }
    } else if constexpr (EPI == EPI_CMP1) {
      bf16_t* H = (bf16_t*)(kv ? g.out1 : g.out0);
      const float* bias = kv ? g.bias1 : g.bias0;
#pragma unroll
      for (int j = 0; j < 2; ++j) {
        const int col = wn * 64 + j * 32 + l32;
        const float bv = bias[col];
#pragma unroll
        for (int e = 0; e < 16; ++e) H[(size_t)(rbase + (e & 3) + 8 * (e >> 2)) * 128 + col] = f2bf(gelu_tanh(acc[i][j][e] + bv));
      }
    } else {
      if (wn == 0) {
#pragma unroll
        for (int j = 0; j < 2; ++j) {
          const int col = j * 32 + l32;
          if (kv == 0) {
            bf16_t* KC = (bf16_t*)g.out0;
#pragma unroll
            for (int e = 0; e < 16; ++e) KC[(size_t)(rbase + (e & 3) + 8 * (e >> 2)) * 64 + col] = f2bf(acc[i][j][e]);
          } else {
            bf16_t* VCT = (bf16_t*)g.out1;
#pragma unroll
            for (int q4 = 0; q4 < 4; ++q4) {
              const int row = rbase + 8 * q4;
              u32x2 v; v.x = pack2(acc[i][j][4 * q4], acc[i][j][4 * q4 + 1]); v.y = pack2(acc[i][j][4 * q4 + 2], acc[i][j][4 * q4 + 3]);
              *(u32x2*)&VCT[((size_t)((row >> 8) * 64 + col)) * 256 + (row & 255)] = v;
            }
          }
        }
      }
    }
  }
}

template <int EPI>
DI void gemm_pair_phase(const GemmArgs& g, char* lds) {
  const int per = g.NTm * g.NTn, total = per * g.nmat;
  const int hf = otid() >> 8;
  for (int id0 = blockIdx.x * 2; id0 < total; id0 += gridDim.x * 2) {
    const int id = id0 + hf;
    const int kv = id / per, idl = id - kv * per;
    int mt, nt; tile_map(idl, g.NTm, g.NTn, mt, nt);
    gemm_tile<EPI>(g, kv, mt, nt, lds + hf * GEMM_LDS);
  }
}

DI void convT(const float* __restrict__ src, int K, int N, int Npad, bf16_t* __restrict__ dst, const float* __restrict__ gain, int mode, char* lds) {
  const int tid512 = otid(), hf0 = tid512 >> 8, tid = tid512 & 255;
  float* tile = (float*)lds + hf0 * (64 * 65);
  const int tk = K >> 6, tn = Npad >> 6, total = tk * tn;
  for (int t0 = blockIdx.x * 2; t0 < total; t0 += gridDim.x * 2) {
    const int t = t0 + hf0;
    const bool act = t < total;
    const int kb = t / tn, nb = t - kb * tn, k0 = kb * 64, n0 = nb * 64;
    __syncthreads();
    if (act) {
      const int n4 = (tid & 15) * 4, n = n0 + n4;
      float sc = 1.f;
      if (mode == 2 && n >= 1536 && n < 2048) sc = 0.125f * 1.4426950408889634f;
      if (mode == 3 && n < 1024) sc = 0.125f * 1.4426950408889634f;
      f32x4 v[4];
#pragma unroll
      for (int i = 0; i < 4; ++i) {
        const int kk = (tid >> 4) + 16 * i;
        v[i] = (n < N) ? *(const f32x4*)&src[(size_t)(k0 + kk) * N + n] : f32x4{0.f, 0.f, 0.f, 0.f};
      }
#pragma unroll
      for (int i = 0; i < 4; ++i) {
        const int kk = (tid >> 4) + 16 * i;
        const float gs = gain ? gain[k0 + kk] * sc : sc;
        tile[kk * 65 + n4 + 0] = v[i].x * gs; tile[kk * 65 + n4 + 1] = v[i].y * gs;
        tile[kk * 65 + n4 + 2] = v[i].z * gs; tile[kk * 65 + n4 + 3] = v[i].w * gs;
      }
    }
    __syncthreads();
    if (act) {
      const int nn = tid >> 2, kc = (tid & 3) * 16, n = n0 + nn;
      int nrow = n;
      if (mode == 1) { const int hf = n >= DFF ? 1 : 0, j = n - hf * DFF; nrow = (j >> 4) * 32 + hf * 16 + (j & 15); }
      u32x4 o0, o1;
      o0.x = pack2(tile[(kc + 0) * 65 + nn], tile[(kc + 1) * 65 + nn]);
      o0.y = pack2(tile[(kc + 2) * 65 + nn], tile[(kc + 3) * 65 + nn]);
      o0.z = pack2(tile[(kc + 4) * 65 + nn], tile[(kc + 5) * 65 + nn]);
      o0.w = pack2(tile[(kc + 6) * 65 + nn], tile[(kc + 7) * 65 + nn]);
      o1.x = pack2(tile[(kc + 8) * 65 + nn], tile[(kc + 9) * 65 + nn]);
      o1.y = pack2(tile[(kc + 10) * 65 + nn], tile[(kc + 11) * 65 + nn]);
      o1.z = pack2(tile[(kc + 12) * 65 + nn], tile[(kc + 13) * 65 + nn]);
      o1.w = pack2(tile[(kc + 14) * 65 + nn], tile[(kc + 15) * 65 + nn]);
      bf16_t* d = dst + (size_t)nrow * K + k0 + kc;
      *(u32x4*)d = o0; *(u32x4*)(d + 8) = o1;
    }
  }
}

DI bf16_t* w_ffn_in(unsigned char* ws, int l, int f) { return (bf16_t*)(ws + OFF_WFFN) + (size_t)(l * 2 + f) * E_FFN; }
DI bf16_t* w_ffn_out(unsigned char* ws, int l, int f) { return w_ffn_in(ws, l, f) + E_FIN; }
DI bf16_t* w_ab(unsigned char* ws, int i) { return (bf16_t*)(ws + OFF_WEVEN) + (size_t)i * E_EVEN; }
DI bf16_t* w_abo(unsigned char* ws, int i) { return w_ab(ws, i) + E_AB; }
DI bf16_t* w_c1(unsigned char* ws, int i, int kv) { return w_abo(ws, i) + E_ABO + (size_t)kv * E_W1; }
DI bf16_t* w_c2(unsigned char* ws, int i, int kv) { return w_abo(ws, i) + E_ABO + 2 * E_W1 + (size_t)kv * E_W2; }
DI bf16_t* w_qkv(unsigned char* ws, int i) { return (bf16_t*)(ws + OFF_WODD) + (size_t)i * E_ODD; }
DI bf16_t* w_sbo(unsigned char* ws, int i) { return w_qkv(ws, i) + E_QKV; }

DI void prep_phase(const Params& p, char* lds) {
  unsigned char* ws = p.ws;
  for (int l = 0; l < 4; ++l) {
    for (int f = 0; f < 2; ++f) {
      const float* win = p.in[f ? 17 : 2] + (size_t)l * 1024 * 5632;
      const float* wout = p.in[f ? 18 : 3] + (size_t)l * 2816 * 1024;
      const float* gn = p.in[f ? 16 : 1] + l * 1024;
      convT(win, 1024, 5632, 5632, w_ffn_in(ws, l, f), gn, 1, lds);
      convT(wout, 2816, 1024, 1024, w_ffn_out(ws, l, f), nullptr, 0, lds);
    }
  }
  for (int i = 0; i < 2; ++i) {
    convT(p.in[5] + (size_t)i * 1024 * 2840, 1024, 2840, 3072, w_ab(ws, i), p.in[4] + (2 * i) * 1024, 2, lds);
    convT(p.in[13] + (size_t)i * 1024 * 1024, 1024, 1024, 1024, w_abo(ws, i), nullptr, 0, lds);
    for (int kv = 0; kv < 2; ++kv) {
      convT(p.in[kv ? 11 : 8] + (size_t)i * 2048 * 128, 2048, 128, 128, w_c1(ws, i, kv), nullptr, 0, lds);
      convT(p.in[kv ? 12 : 9] + (size_t)i * 128 * 64, 128, 64, 128, w_c2(ws, i, kv), nullptr, 0, lds);
    }
    convT(p.in[14] + (size_t)i * 1024 * 3072, 1024, 3072, 3072, w_qkv(ws, i), p.in[4] + (2 * i + 1) * 1024, 3, lds);
    convT(p.in[15] + (size_t)i * 1024 * 1024, 1024, 1024, 1024, w_sbo(ws, i), nullptr, 0, lds);
  }
  const int lane = otid() & 63, gw = blockIdx.x * 8 + (otid() >> 6), nw = gridDim.x * 8;
  float* bias = (float*)(ws + OFF_BIAS);
  for (int o = gw; o < 512; o += nw) {
    const int i = o >> 8, kv = (o >> 7) & 1, j = o & 127;
    const float* pe = p.in[kv ? 10 : 7] + (size_t)i * 2048;
    const float* w1 = p.in[kv ? 11 : 8] + (size_t)i * 2048 * 128;
    float s = 0.f;
    for (int k = lane; k < 2048; k += 64) s += pe[k] * w1[(size_t)k * 128 + j];
    s = wave_sum(s);
    if (lane == 0) bias[o] = s;
  }
}

DI void rownorm_phase(const float* __restrict__ src, bf16_t* __restrict__ dst) {
  const int lane = otid() & 63, gw = blockIdx.x * 8 + (otid() >> 6), nw = gridDim.x * 8;
  for (int row = gw; row < NT; row += nw) {
    const f32x4* xr = (const f32x4*)(src + (size_t)row * DM) + lane;
    f32x4 v[4]; float s = 0.f;
#pragma unroll
    for (int j = 0; j < 4; ++j) { v[j] = xr[64 * j]; s += v[j].x * v[j].x + v[j].y * v[j].y + v[j].z * v[j].z + v[j].w * v[j].w; }
    s = wave_sum(s);
    const float rstd = rsqrtf(s * (1.f / DM) + 1e-6f);
    u32x2* o = (u32x2*)(dst + (size_t)row * DM) + lane;
#pragma unroll
    for (int j = 0; j < 4; ++j) { u32x2 w; w.x = pack2(v[j].x * rstd, v[j].y * rstd); w.y = pack2(v[j].z * rstd, v[j].w * rstd); o[64 * j] = w; }
  }
}
DI void finalnorm_phase(float* __restrict__ X, const float* __restrict__ gain) {
  const int lane = otid() & 63, gw = blockIdx.x * 8 + (otid() >> 6), nw = gridDim.x * 8;
  for (int row = gw; row < NT; row += nw) {
    f32x4* xr = (f32x4*)(X + (size_t)row * DM) + lane;
    const f32x4* gr = (const f32x4*)gain + lane;
    f32x4 v[4]; float s = 0.f;
#pragma unroll
    for (int j = 0; j < 4; ++j) { v[j] = xr[64 * j]; s += v[j].x * v[j].x + v[j].y * v[j].y + v[j].z * v[j].z + v[j].w * v[j].w; }
    s = wave_sum(s);
    const float rstd = rsqrtf(s * (1.f / DM) + 1e-6f);
#pragma unroll
    for (int j = 0; j < 4; ++j) { const f32x4 gg = gr[64 * j]; f32x4 w; w.x = v[j].x * rstd * gg.x; w.y = v[j].y * rstd * gg.y; w.z = v[j].z * rstd * gg.z; w.w = v[j].w * rstd * gg.w; xr[64 * j] = w; }
  }
}

DI void conv_item(const bf16_t* __restrict__ P, const float* __restrict__ cw, bf16_t* __restrict__ Y, int item) {
  const int tid = otid() & 255;
  const int t0 = item * 32 + (tid >> 6) * 8, c0 = (tid & 63) * 8;
  const int tb = t0 & (SEQ - 1);
  float w0[8], w1[8], w2[8], u1[8], u2[8];
#pragma unroll
  for (int e = 0; e < 8; ++e) { w0[e] = cw[c0 + e]; w1[e] = cw[512 + c0 + e]; w2[e] = cw[1024 + c0 + e]; u1[e] = 0.f; u2[e] = 0.f; }
  if (tb >= 1) {
    const bf16_t* r = P + (size_t)(t0 - 1) * LDP_E + c0;
    const u32x4 c = *(const u32x4*)(r + 512), h = *(const u32x4*)(r + 1024);
    u1[0] = bflo(c.x) * bflo(h.x); u1[1] = bfhi(c.x) * bfhi(h.x); u1[2] = bflo(c.y) * bflo(h.y); u1[3] = bfhi(c.y) * bfhi(h.y);
    u1[4] = bflo(c.z) * bflo(h.z); u1[5] = bfhi(c.z) * bfhi(h.z); u1[6] = bflo(c.w) * bflo(h.w); u1[7] = bfhi(c.w) * bfhi(h.w);
  }
  if (tb >= 2) {
    const bf16_t* r = P + (size_t)(t0 - 2) * LDP_E + c0;
    const u32x4 c = *(const u32x4*)(r + 512), h = *(const u32x4*)(r + 1024);
    u2[0] = bflo(c.x) * bflo(h.x); u2[1] = bfhi(c.x) * bfhi(h.x); u2[2] = bflo(c.y) * bflo(h.y); u2[3] = bfhi(c.y) * bfhi(h.y);
    u2[4] = bflo(c.z) * bflo(h.z); u2[5] = bfhi(c.z) * bfhi(h.z); u2[6] = bflo(c.w) * bflo(h.w); u2[7] = bfhi(c.w) * bfhi(h.w);
  }
#pragma unroll
  for (int tt = 0; tt < 8; ++tt) {
    const bf16_t* r = P + (size_t)(t0 + tt) * LDP_E + c0;
    const u32x4 bq = *(const u32x4*)r, c = *(const u32x4*)(r + 512), h = *(const u32x4*)(r + 1024);
    float u0[8], bb[8], y[8];
    u0[0] = bflo(c.x) * bflo(h.x); u0[1] = bfhi(c.x) * bfhi(h.x); u0[2] = bflo(c.y) * bflo(h.y); u0[3] = bfhi(c.y) * bfhi(h.y);
    u0[4] = bflo(c.z) * bflo(h.z); u0[5] = bfhi(c.z) * bfhi(h.z); u0[6] = bflo(c.w) * bflo(h.w); u0[7] = bfhi(c.w) * bfhi(h.w);
    bb[0] = bflo(bq.x); bb[1] = bfhi(bq.x); bb[2] = bflo(bq.y); bb[3] = bfhi(bq.y); bb[4] = bflo(bq.z); bb[5] = bfhi(bq.z); bb[6] = bflo(bq.w); bb[7] = bfhi(bq.w);
#pragma unroll
    for (int e = 0; e < 8; ++e) { y[e] = bb[e] * (w0[e] * u2[e] + w1[e] * u1[e] + w2[e] * u0[e]); u2[e] = u1[e]; u1[e] = u0[e]; }
    u32x4 o; o.x = pack2(y[0], y[1]); o.y = pack2(y[2], y[3]); o.z = pack2(y[4], y[5]); o.w = pack2(y[6], y[7]);
    *(u32x4*)&Y[(size_t)(t0 + tt) * DM + c0] = o;
  }
}

DI void load_tile64(bf16_t* dst, const bf16_t* __restrict__ src, size_t stride) {
  const int c = otid(), row = c >> 3, col = (c & 7) * 8;
  *(u32x4*)&dst[row * LDT + col] = *(const u32x4*)&src[(size_t)row * stride + col];
}
DI u32x4 tile_fetch(const bf16_t* __restrict__ src, size_t stride) {
  const int c = otid(), row = c >> 3, col = (c & 7) * 8;
  return *(const u32x4*)&src[(size_t)row * stride + col];
}
DI void tile_commit(bf16_t* dst, const u32x4& v) {
  const int c = otid(), row = c >> 3, col = (c & 7) * 8;
  *(u32x4*)&dst[row * LDT + col] = v;
}
DI void qk_tile(const bf16_t* Ks, const bf16x8 (&qf)[4], f32x16 (&S)[2], int l32, int hh) {
  bf16x8 kf[2][4];
#pragma unroll
  for (int kt2 = 0; kt2 < 2; ++kt2)
#pragma unroll
    for (int s = 0; s < 4; ++s) kf[kt2][s] = *(const bf16x8*)&Ks[(kt2 * 32 + l32) * LDT + s * 16 + hh * 8];
  __builtin_amdgcn_sched_barrier(0);
#pragma unroll
  for (int kt2 = 0; kt2 < 2; ++kt2)
#pragma unroll
    for (int e = 0; e < 16; ++e) S[kt2][e] = 0.f;
  __builtin_amdgcn_s_setprio(1);
#pragma unroll
  for (int s = 0; s < 4; ++s)
#pragma unroll
    for (int kt2 = 0; kt2 < 2; ++kt2) S[kt2] = MFMA32(kf[kt2][s], qf[s], S[kt2]);
  __builtin_amdgcn_s_setprio(0);
}
DI void pv_tile(const bf16_t* VTs, const f32x16 (&Pm)[2], f32x16 (&O)[2], int l32, int hh) {
#pragma unroll
  for (int kt2 = 0; kt2 < 2; ++kt2) {
    u32x2 lo[2][2], hi[2][2];
#pragma unroll
    for (int t = 0; t < 2; ++t)
#pragma unroll
      for (int dt = 0; dt < 2; ++dt) {
        const bf16_t* vp = &VTs[(dt * 32 + l32) * LDT + kt2 * 32 + 16 * t + 4 * hh];
        lo[t][dt] = *(const u32x2*)vp; hi[t][dt] = *(const u32x2*)(vp + 8);
      }
    __builtin_amdgcn_sched_barrier(0);
    __builtin_amdgcn_s_setprio(1);
#pragma unroll
    for (int t = 0; t < 2; ++t) {
      u32x4 pk;
      pk.x = pack2(Pm[kt2][8 * t + 0], Pm[kt2][8 * t + 1]); pk.y = pack2(Pm[kt2][8 * t + 2], Pm[kt2][8 * t + 3]);
      pk.z = pack2(Pm[kt2][8 * t + 4], Pm[kt2][8 * t + 5]); pk.w = pack2(Pm[kt2][8 * t + 6], Pm[kt2][8 * t + 7]);
      const bf16x8 pf = __builtin_bit_cast(bf16x8, pk);
#pragma unroll
      for (int dt = 0; dt < 2; ++dt) {
        u32x4 vv; vv.x = lo[t][dt].x; vv.y = lo[t][dt].y; vv.z = hi[t][dt].x; vv.w = hi[t][dt].y;
        O[dt] = MFMA32(__builtin_bit_cast(bf16x8, vv), pf, O[dt]);
      }
    }
    __builtin_amdgcn_s_setprio(0);
  }
}
DI float ex2(float x) { return __builtin_amdgcn_exp2f(x); }
template <bool HAS_O>
DI void softmax_finish(f32x16 (&S)[2], float mx, float cbias, float& m, float& l, f32x16 (&O)[2]) {
  mx = half_max(mx);
  const float mn = (mx > m + 8.f) ? mx : m;
  const float alpha = ex2(m - mn);
  m = mn;
  const float c = mn + cbias;
  float sum = 0.f;
#pragma unroll
  for (int kt2 = 0; kt2 < 2; ++kt2)
#pragma unroll
    for (int e = 0; e < 16; ++e) { const float pv = ex2(S[kt2][e] - c); S[kt2][e] = pv; sum += pv; }
  l = l * alpha + sum;
  if constexpr (HAS_O) {
    if (__ballot(alpha != 1.f) != 0ull) {
#pragma unroll
      for (int dt = 0; dt < 2; ++dt)
#pragma unroll
        for (int e = 0; e < 16; ++e) O[dt][e] *= alpha;
    }
  }
}
template <bool HAS_O, class MaskF>
DI void softmax_step(f32x16 (&S)[2], float& m, float& l, f32x16 (&O)[2], int hh, MaskF mask) {
  float mx = -1e30f;
#pragma unroll
  for (int kt2 = 0; kt2 < 2; ++kt2)
#pragma unroll
    for (int e = 0; e < 16; ++e) {
      const float sv = mask(kt2 * 32 + crow(e, hh)) ? S[kt2][e] : -1e30f;
      S[kt2][e] = sv; mx = fmaxf(mx, sv);
    }
  softmax_finish<HAS_O>(S, mx, 0.f, m, l, O);
}
template <bool HAS_O>
DI void softmax_fast(f32x16 (&S)[2], float& m, float& l, f32x16 (&O)[2], bool live) {
  float mx = S[0][0];
#pragma unroll
  for (int kt2 = 0; kt2 < 2; ++kt2)
#pragma unroll
    for (int e = 0; e < 16; ++e) mx = fmaxf(mx, S[kt2][e]);
  softmax_finish<HAS_O>(S, live ? mx : -1e30f, live ? 0.f : 1e30f, m, l, O);
}

constexpr int NSA_SLAB_OFF = 8 * 64 * LDT * 2;
constexpr int NSA_SELM_OFF = NSA_SLAB_OFF + 4 * 64 * 64 * 4;
DI void nsa_item(const bf16_t* __restrict__ P, const bf16_t* __restrict__ KC, const bf16_t* __restrict__ VCT,
                 const bf16_t* __restrict__ VTS, const bf16_t* __restrict__ VTW, bf16_t* __restrict__ Y, int item, char* lds) {
  const int tid = otid(), lane = tid & 63, wave = tid >> 6, l32 = lane & 31, hh = lane >> 5;
  const int xq = (item >> 4) & 15, rnd = item >> 8;
  const int qb = rnd == 0 ? 63 - xq : (rnd == 1 ? xq : (rnd == 2 ? 47 - xq : 16 + xq));
  const int bg = item & 15, b = bg >> 1, g = bg & 1;
  const int hr = wave & 3, qh = wave >> 2;
  const int q0 = qb * 64, cur = qb, pos = q0 + qh * 32 + l32, h = g * 4 + hr;
  const size_t tokbase = (size_t)b * SEQ;
  bf16_t* Ks = (bf16_t*)lds;
  bf16_t* VTs = Ks + 64 * LDT;
  float* slab = (float*)(lds + NSA_SLAB_OFF);
  u64* selm = (u64*)(lds + NSA_SELM_OFF);

  bf16x8 qf[4];
  {
    const bf16_t* qp = P + (tokbase + pos) * LDP_E + 1536 + h * 64 + hh * 8;
#pragma unroll
    for (int s = 0; s < 4; ++s) qf[s] = *(const bf16x8*)(qp + s * 16);
  }
  float g0, g1, g2;
  {
    const bf16_t* gp = P + (tokbase + pos) * LDP_E + 2816 + h * 3;
    g0 = sigmoidf(bf2f(gp[0])); g1 = sigmoidf(bf2f(gp[1])); g2 = sigmoidf(bf2f(gp[2]));
  }
  f32x16 O[2], S[2];
#pragma unroll
  for (int dt = 0; dt < 2; ++dt)
#pragma unroll
    for (int e = 0; e < 16; ++e) O[dt][e] = 0.f;

  const int nct = (((q0 + 32) >> 4) >> 6) + 1;
  const bf16_t* kcb = KC + (size_t)bg * 256 * 64;
  const bf16_t* vcb = VCT + (size_t)bg * 64 * 256;
  float m = -1e29f, l = 0.f;
  u32x4 pfk = tile_fetch(kcb, 64), pfv = pfk;
#pragma unroll 1
  for (int ct = 0; ct < nct; ++ct) {
    __syncthreads();
    tile_commit(Ks, pfk);
    __syncthreads();
    { const int cn = ct + 1 < nct ? ct + 1 : 0;
      pfk = tile_fetch(kcb + (size_t)cn * 64 * 64, 64); pfv = tile_fetch(vcb + cn * 64, 256);
      __builtin_amdgcn_sched_barrier(0); }
    qk_tile(Ks, qf, S, l32, hh);
    softmax_step<false>(S, m, l, O, hh, [&](int kk) { return 16 * (ct * 64 + kk) + 31 <= pos; });
  }
  {
    const float lt = half_sum(l);
    const float inv = lt > 0.f ? 1.f / lt : 0.f;
    float carry3 = 0.f;
    float* myslab = slab + (hr * 64 + qh * 32 + l32) * 64;
#pragma unroll 1
    for (int ct = 0; ct < nct; ++ct) {
      __syncthreads();
      tile_commit(Ks, pfk); tile_commit(VTs, pfv);
      __syncthreads();
      { const int cn = ct + 1 < nct ? ct + 1 : ct;
        pfk = tile_fetch(kcb + (size_t)cn * 64 * 64, 64); pfv = tile_fetch(vcb + cn * 64, 256);
        __builtin_amdgcn_sched_barrier(0); }
      qk_tile(Ks, qf, S, l32, hh);
#pragma unroll
      for (int kt2 = 0; kt2 < 2; ++kt2) {
#pragma unroll
        for (int e = 0; e < 16; ++e) {
          const bool ok = 16 * (ct * 64 + kt2 * 32 + crow(e, hh)) + 31 <= pos;
          S[kt2][e] = ok ? ex2(S[kt2][e] - m) * inv : 0.f;
        }
        float x[4];
#pragma unroll
        for (int j = 0; j < 4; ++j) x[j] = half_other(S[kt2][4 * j + 3], hh);
#pragma unroll
        for (int j = 0; j < 4; ++j) {
          const float prev3 = hh ? x[j] : (j > 0 ? x[j - 1] : carry3);
          const float own = S[kt2][4 * j] + S[kt2][4 * j + 1] + S[kt2][4 * j + 2] + 0.5f * S[kt2][4 * j + 3] + 0.5f * prev3;
          myslab[ct * 16 + kt2 * 8 + 2 * j + hh] = own;
        }
        carry3 = x[3];
#pragma unroll
        for (int e = 0; e < 16; ++e) S[kt2][e] *= g0;
      }
      pv_tile(VTs, S, O, l32, hh);
    }
  }
  __syncthreads();
  {
    const int q = tid >> 3, sub = tid & 7;
    float v[8];
#pragma unroll
    for (int e = 0; e < 8; ++e) {
      const int s = sub * 8 + e;
      v[e] = 0.f;
      if (s <= cur) v[e] = slab[(0 * 64 + q) * 64 + s] + slab[(1 * 64 + q) * 64 + s] + slab[(2 * 64 + q) * 64 + s] + slab[(3 * 64 + q) * 64 + s];
    }
    __syncthreads();
#pragma unroll
    for (int e = 0; e < 8; ++e) { const int s = sub * 8 + e; if (s <= cur) slab[q * 64 + s] = v[e]; }
    __syncthreads();
    unsigned bits = 0;
    if (cur + 1 <= 16) {
#pragma unroll
      for (int e = 0; e < 8; ++e) if (sub * 8 + e <= cur) bits |= 1u << e;
    } else {
      int rank[8];
      u64 key[8];
#pragma unroll
      for (int e = 0; e < 8; ++e) { rank[e] = 0; key[e] = ((u64)__float_as_uint(v[e]) << 32) | (u64)(unsigned)(63 - (sub * 8 + e)); }
#pragma unroll 1
      for (int s2 = 1; s2 <= cur - 2; ++s2) {
        const u64 k2 = ((u64)__float_as_uint(slab[q * 64 + s2]) << 32) | (u64)(unsigned)(63 - s2);
#pragma unroll
        for (int e = 0; e < 8; ++e) rank[e] += (k2 > key[e]) ? 1 : 0;
      }
#pragma unroll
      for (int e = 0; e < 8; ++e) {
        const int s = sub * 8 + e;
        const bool forced = (s == 0) || (s == cur) || (s == cur - 1);
        if (s <= cur && (forced || rank[e] < 13)) bits |= 1u << e;
      }
    }
    unsigned lo = sub < 4 ? (bits << (8 * sub)) : 0u, hi = sub >= 4 ? (bits << (8 * (sub - 4))) : 0u;
#pragma unroll
    for (int o = 1; o < 8; o <<= 1) { lo |= __shfl_xor(lo, o); hi |= __shfl_xor(hi, o); }
    if (sub == 0) selm[q] = ((u64)hi << 32) | lo;
  }
  __syncthreads();
  u64 um = 0;
#pragma unroll 4
  for (int q = 0; q < 64; ++q) um |= selm[q];
  const u64 mym = selm[qh * 32 + l32];
  float* stash = slab + tid;
#pragma unroll
  for (int dt = 0; dt < 2; ++dt)
#pragma unroll
    for (int e = 0; e < 16; ++e) { stash[(dt * 16 + e) * 512] = O[dt][e]; O[dt][e] = 0.f; }

  const bf16_t* ks0 = P + tokbase * LDP_E + 2304 + g * 64;
  const bf16_t* vs0 = VTS + (size_t)bg * 64 * SEQ;
  const bf16_t* kw0 = P + tokbase * LDP_E + 2560 + g * 64;
  const bf16_t* vw0 = VTW + (size_t)bg * 64 * SEQ;
  const int kbs = cur - 8 > 0 ? cur - 8 : 0;
  m = -1e29f; l = 0.f;
  {
    constexpr int TS = 64 * LDT;
    u64 rem = um;
    int sk = 0, si = 0;
    auto advance = [&]() {
      if (sk == 0) { if (rem) { si = __builtin_ctzll(rem); rem &= rem - 1; } else { sk = 1; si = kbs; } }
      else if (sk == 1) { if (si < cur) ++si; else sk = 2; }
    };
    u32x4 pfk1 = pfk, pfv1 = pfv;
    auto fetch1 = [&](int kd, int ix, u32x4& rk, u32x4& rv) {
      const int iv = kd < 2 ? ix : 0;
      const bf16_t* kp = (kd == 0 ? ks0 : kw0) + (size_t)iv * 64 * LDP_E;
      const bf16_t* vp = (kd == 0 ? vs0 : vw0) + iv * 64;
      rk = tile_fetch(kp, LDP_E); rv = tile_fetch(vp, SEQ);
    };
    auto do_tile = [&](int kd, int ix, const bf16_t* kbuf, int knext) {
      qk_tile(kbuf, qf, S, l32, hh);
      if (kd == 0) {
        const bool mine = (mym >> ix) & 1ull;
        if (ix < cur) softmax_fast<true>(S, m, l, O, mine);
        else softmax_step<true>(S, m, l, O, hh, [&](int kk) { return mine && (ix * 64 + kk <= pos); });
      } else {
        if (ix < cur && ix > cur - 8) softmax_fast<true>(S, m, l, O, true);
        else softmax_step<true>(S, m, l, O, hh, [&](int kk) { const int kp = ix * 64 + kk; return kp <= pos && kp > pos - 512; });
      }
      pv_tile(kbuf + TS, S, O, l32, hh);
      if (kd == 0 && knext != 0) {
        const float lt = half_sum(l);
        const float sc = lt > 0.f ? g1 / lt : 0.f;
#pragma unroll
        for (int dt = 0; dt < 2; ++dt)
#pragma unroll
          for (int e = 0; e < 16; ++e) { stash[(dt * 16 + e) * 512] += O[dt][e] * sc; O[dt][e] = 0.f; }
        m = -1e29f; l = 0.f;
      }
    };
    sk = 0; si = __builtin_ctzll(rem); rem &= rem - 1;
    int ka0 = sk, ia0 = si; advance(); int ka1 = sk, ia1 = si;
    fetch1(ka0, ia0, pfk, pfv); fetch1(ka1, ia1, pfk1, pfv1);
    __syncthreads();
    tile_commit(Ks, pfk); tile_commit(Ks + TS, pfv); tile_commit(Ks + 2 * TS, pfk1); tile_commit(Ks + 3 * TS, pfv1);
    advance(); int kb0_ = sk, ib0 = si; advance(); int kb1_ = sk, ib1 = si;
    fetch1(kb0_, ib0, pfk, pfv); fetch1(kb1_, ib1, pfk1, pfv1);
    __syncthreads();
    int par = 0;
#pragma unroll 1
    for (;;) {
      const bf16_t* bcur = Ks + par * (4 * TS);
      bf16_t* bnxt = Ks + (par ^ 1) * (4 * TS);
      tile_commit(bnxt, pfk); tile_commit(bnxt + TS, pfv); tile_commit(bnxt + 2 * TS, pfk1); tile_commit(bnxt + 3 * TS, pfv1);
      advance(); const int kc0 = sk, ic0 = si; advance(); const int kc1 = sk, ic1 = si;
      fetch1(kc0, ic0, pfk, pfv); fetch1(kc1, ic1, pfk1, pfv1);
      __builtin_amdgcn_sched_barrier(0);
      do_tile(ka0, ia0, bcur, ka1);
      if (ka1 < 2) do_tile(ka1, ia1, bcur + 2 * TS, kb0_);
      if (kb0_ == 2) break;
      __syncthreads();
      ka0 = kb0_; ia0 = ib0; ka1 = kb1_; ia1 = ib1; kb0_ = kc0; ib0 = ic0; kb1_ = kc1; ib1 = ic1; par ^= 1;
    }
    const float lt = half_sum(l);
    const float sc = lt > 0.f ? g2 / lt : 0.f;
#pragma unroll
    for (int dt = 0; dt < 2; ++dt)
#pragma unroll
      for (int e = 0; e < 16; ++e) O[dt][e] = stash[(dt * 16 + e) * 512] + O[dt][e] * sc;
  }
  bf16_t* yp = Y + (tokbase + pos) * DM + 512 + h * 64 + 4 * hh;
#pragma unroll
  for (int dt = 0; dt < 2; ++dt)
#pragma unroll
    for (int j = 0; j < 4; ++j) {
      u32x2 v; v.x = pack2(O[dt][4 * j], O[dt][4 * j + 1]); v.y = pack2(O[dt][4 * j + 2], O[dt][4 * j + 3]);
      *(u32x2*)(yp + dt * 32 + 8 * j) = v;
    }
}

DI void sb_item(const bf16_t* __restrict__ P, const bf16_t* __restrict__ VT, bf16_t* __restrict__ Y, int item, char* lds) {
  const int tid = otid(), lane = tid & 63, wave = tid >> 6, l32 = lane & 31, hh = lane >> 5;
  const int qb = item & 15, bh = item >> 4, b = bh >> 4, hd = bh & 15;
  const int q0 = qb * 256 + wave * 32, qpos = q0 + l32;
  const size_t tokbase = (size_t)b * SEQ;
  bf16_t* Ks = (bf16_t*)lds;
  bf16_t* VTs = Ks + 64 * LDT;
  bf16x8 qf[4];
  {
    const bf16_t* qp = P + (tokbase + qpos) * LDP_O + hd * 64 + hh * 8;
#pragma unroll
    for (int s = 0; s < 4; ++s) qf[s] = *(const bf16x8*)(qp + s * 16);
  }
  f32x16 O[2], S[2];
#pragma unroll
  for (int dt = 0; dt < 2; ++dt)
#pragma unroll
    for (int e = 0; e < 16; ++e) O[dt][e] = 0.f;
  float carry = 1.f;
  const bf16_t* kb0 = P + tokbase * LDP_O + 1024 + hd * 64;
  const bf16_t* vb0 = VT + (size_t)bh * 64 * SEQ;
  const int kbs = 4 * qb + 3;
  constexpr int TS = 64 * LDT;
  u32x4 pfk = tile_fetch(kb0 + (size_t)kbs * 64 * LDP_O, LDP_O), pfv = tile_fetch(vb0 + kbs * 64, SEQ);
  u32x4 pfk1 = tile_fetch(kb0 + (size_t)(kbs - 1) * 64 * LDP_O, LDP_O), pfv1 = tile_fetch(vb0 + (kbs - 1) * 64, SEQ);
  __syncthreads();
  tile_commit(Ks, pfk); tile_commit(Ks + TS, pfv); tile_commit(Ks + 2 * TS, pfk1); tile_commit(Ks + 3 * TS, pfv1);
  if (kbs >= 3) {
    pfk = tile_fetch(kb0 + (size_t)(kbs - 2) * 64 * LDP_O, LDP_O); pfv = tile_fetch(vb0 + (kbs - 2) * 64, SEQ);
    pfk1 = tile_fetch(kb0 + (size_t)(kbs - 3) * 64 * LDP_O, LDP_O); pfv1 = tile_fetch(vb0 + (kbs - 3) * 64, SEQ);
  }
  __syncthreads();
  int par = 0, fi = 0;
  volatile int* flags = (volatile int*)(lds + LDS_BYTES + 16);
  auto do_tile = [&](int kb, const bf16_t* kcur) {
    const bool active = (kb * 64 < q0 + 31) && (__ballot(carry > 0.f) != 0ull);
    if (active) {
      qk_tile(kcur, qf, S, l32, hh);
      const bool full = kb * 64 + 63 < q0;
#pragma unroll
      for (int kt2 = 1; kt2 >= 0; --kt2) {
        float st[16];
#pragma unroll
        for (int e = 0; e < 16; ++e) {
          const float ez = ex2(S[kt2][e]);
          const float r = __builtin_amdgcn_rcpf(1.f + ez);
          const bool vis = full || (kb * 64 + kt2 * 32 + crow(e, hh) < qpos);
          st[e] = vis ? r : 1.f;
          S[kt2][e] = vis ? 1.f - r : 0.f;
        }
        float G[4], Go[4];
#pragma unroll
        for (int j = 0; j < 4; ++j) { G[j] = (st[4 * j] * st[4 * j + 1]) * (st[4 * j + 2] * st[4 * j + 3]); Go[j] = half_other(G[j], hh); }
        float T = carry;
#pragma unroll
        for (int j = 3; j >= 0; --j) {
          float run = hh ? T : T * Go[j];
#pragma unroll
          for (int e = 3; e >= 0; --e) {
            const int idx = 4 * j + e;
            S[kt2][idx] *= run;
            run *= st[idx];
          }
          T *= G[j] * Go[j];
        }
        carry = T;
      }
      pv_tile(kcur + TS, S, O, l32, hh);
    }
  };
#pragma unroll 1
  for (int kb = kbs; kb >= 1; kb -= 2) {
    const bf16_t* bcur = Ks + par * (4 * TS);
    bf16_t* bnxt = Ks + (par ^ 1) * (4 * TS);
    tile_commit(bnxt, pfk); tile_commit(bnxt + TS, pfv); tile_commit(bnxt + 2 * TS, pfk1); tile_commit(bnxt + 3 * TS, pfv1);
    {
      const int f0 = kb >= 5 ? kb - 4 : 1, f1 = kb >= 5 ? kb - 5 : 0;
      pfk = tile_fetch(kb0 + (size_t)f0 * 64 * LDP_O, LDP_O); pfv = tile_fetch(vb0 + f0 * 64, SEQ);
      pfk1 = tile_fetch(kb0 + (size_t)f1 * 64 * LDP_O, LDP_O); pfv1 = tile_fetch(vb0 + f1 * 64, SEQ);
      __builtin_amdgcn_sched_barrier(0); }
    par ^= 1;
    do_tile(kb, bcur);
    do_tile(kb - 1, bcur + 2 * TS);
    if (carry > 0.f) flags[fi] = 1;
    __syncthreads();
    const int cont = flags[fi];
    const int fz = fi >= 1 ? fi - 1 : 2;
    if (tid == 0) flags[fz] = 0;
    fi = fi == 2 ? 0 : fi + 1;
    if (!cont) break;
  }
  bf16_t* yp = Y + (tokbase + qpos) * DM + hd * 64 + 4 * hh;
#pragma unroll
  for (int dt = 0; dt < 2; ++dt)
#pragma unroll
    for (int j = 0; j < 4; ++j) {
      u32x2 v; v.x = pack2(O[dt][4 * j], O[dt][4 * j + 1]); v.y = pack2(O[dt][4 * j + 2], O[dt][4 * j + 3]);
      *(u32x2*)(yp + dt * 32 + 8 * j) = v;
    }
}


#define XB_TMO      128
#define XB_XCNT(j)  (256  + 64 * (j))
#define XB_XSUB(j)  (1280 + 64 * (j))
#define XB_XGEN(j)  (2304 + 64 * (j))
#define XB_TOP      3328
#define XB_TOPGEN   3392
#define XCD_BAR_WORDS 3456
#define XB_SPIN_CAP (1u << 22)
#define LAS __attribute__((address_space(3)))
DI unsigned xb_ld(unsigned* p) { return __hip_atomic_load(p, __ATOMIC_RELAXED, __HIP_MEMORY_SCOPE_AGENT); }
DI unsigned xb_add(unsigned* p, unsigned v) { return __hip_atomic_fetch_add(p, v, __ATOMIC_RELAXED, __HIP_MEMORY_SCOPE_AGENT); }
DI unsigned xb_xcc_id() { return (unsigned)__builtin_amdgcn_s_getreg((3 << 11) | 20) & 0xFu; }
#define XB_SPIN(cond, bar) do { unsigned _sp = 0; while (cond) { \
    if ((++_sp & 255u) == 0u) { if (xb_ld(&(bar)[XB_TMO])) break; if (_sp > XB_SPIN_CAP) { atomicAdd(&(bar)[XB_TMO], 1u); break; } } } } while (0)
struct XcdBarrier { unsigned* bar; unsigned x; volatile LAS unsigned* st; };
DI XcdBarrier xcd_barrier_post(unsigned* bar, volatile LAS unsigned* st) {
  XcdBarrier b; b.bar = bar; b.x = xb_xcc_id(); b.st = st;
  if (threadIdx.x == 0) (void)xb_add(&bar[XB_XCNT(b.x)], 1u);
  return b;
}
DI void xcd_barrier_complete(unsigned* bar, unsigned x, unsigned& nloc, unsigned& nx) {
  const unsigned G = gridDim.x * gridDim.y * gridDim.z;
  unsigned sum, cnt, mine, sp = 0u;
  for (;;) {
    sum = 0u; cnt = 0u; mine = 0u;
#pragma unroll
    for (unsigned j = 0; j < 16; ++j) { const unsigned c = xb_ld(&bar[XB_XCNT(j)]); sum += c; cnt += (c > 0u) ? 1u : 0u; mine = (j == x) ? c : mine; }
    if (sum == G) break;
    __builtin_amdgcn_s_sleep(1);
    if ((++sp & 255u) == 0u) { if (xb_ld(&bar[XB_TMO])) break; if (sp > XB_SPIN_CAP) { atomicAdd(&bar[XB_TMO], 1u); break; } }
  }
  nloc = mine > 0u ? mine : 1u; nx = cnt > 0u ? cnt : 1u;
}
DI void xcd_barrier(const XcdBarrier& b) {
  asm volatile("s_waitcnt vmcnt(0)" ::: "memory");
  __syncthreads();
  if (threadIdx.x == 0) {
    unsigned* bar = b.bar;
    __builtin_amdgcn_s_waitcnt(0);
    unsigned nloc = b.st[0], nx = b.st[1];
    if (nloc == 0u) { xcd_barrier_complete(bar, b.x, nloc, nx); b.st[0] = nloc; b.st[1] = nx; }
    const unsigned old = xb_add(&bar[XB_XSUB(b.x)], 1u);
    const unsigned gen = old / nloc;
    if (old + 1u == (gen + 1u) * nloc) {
      __builtin_amdgcn_fence(__ATOMIC_RELEASE, "agent");
      asm volatile("s_waitcnt vmcnt(0)" ::: "memory");
      const unsigned og = xb_add(&bar[XB_TOP], 1u);
      const unsigned tg = og / nx;
      if (og + 1u == (tg + 1u) * nx) xb_add(&bar[XB_TOPGEN], 1u);
      else XB_SPIN(xb_ld(&bar[XB_TOPGEN]) == tg, bar);
      __builtin_amdgcn_fence(__ATOMIC_ACQUIRE, "agent");
      xb_add(&bar[XB_XGEN(b.x)], 1u);
      asm volatile("s_waitcnt vmcnt(0)" ::: "memory");
    } else {
      XB_SPIN(xb_ld(&bar[XB_XGEN(b.x)]) == gen, bar);
      __builtin_amdgcn_fence(__ATOMIC_ACQUIRE, "agent");
      asm volatile("s_waitcnt vmcnt(0)" ::: "memory");
    }
  }
  __syncthreads();
}


namespace g8 {
constexpr int BK = 64, HALF = 128, HT = HALF * BK;
DI int lds_byte(int r, int c) { const int st = (r >> 4) * 2 + (c >> 5), rr = r & 15, cc = c & 31, ob = rr * 64 + cc * 2; return st * 1024 + (ob ^ (((ob >> 9) & 1) << 5)); }
DI void stage_rc(int b, int& R, int& C) { const int st = b / 1024, sb = b % 1024, swz = sb ^ (((sb >> 9) & 1) << 5); R = (st >> 1) * 16 + swz / 64; C = (st & 1) * 32 + (swz % 64) / 2; }
}

DI void gemm8_resid_epilogue(const GemmArgs& g, f32x4 (&acc)[2][2][4][2], const int brow, const int bcol, const int wr, const int wc, const int fr, const int fq) {
  float* X = (float*)g.out0;
  const float* src = g.src;
  const float sc = g.scale;
  auto base = [&](int ai, int bj) -> size_t { return (size_t)(brow + ai * 128 + wr * 64 + fr) * DM + bcol + bj * 128 + wc * 32 + fq * 4; };
  f32x4 ra[4][2], rb[4][2];
  auto ld = [&](f32x4 (&r)[4][2], size_t ib) {
#pragma unroll
    for (int m = 0; m < 4; ++m)
#pragma unroll
      for (int n = 0; n < 2; ++n) r[m][n] = *(const f32x4*)(src + ib + (size_t)(m * 16) * DM + n * 16);
  };
  auto st = [&](const f32x4 (&r)[4][2], const f32x4 (&a)[4][2], size_t ib) {
#pragma unroll
    for (int m = 0; m < 4; ++m)
#pragma unroll
      for (int n = 0; n < 2; ++n) {
        f32x4 o;
        o.x = r[m][n].x + sc * a[m][n][0]; o.y = r[m][n].y + sc * a[m][n][1];
        o.z = r[m][n].z + sc * a[m][n][2]; o.w = r[m][n].w + sc * a[m][n][3];
        *(f32x4*)(X + ib + (size_t)(m * 16) * DM + n * 16) = o;
      }
  };
  const size_t b00 = base(0, 0), b01 = base(0, 1), b10 = base(1, 0), b11 = base(1, 1);
  ld(ra, b00); ld(rb, b01);
  st(ra, acc[0][0], b00); ld(ra, b10);
  st(rb, acc[0][1], b01); ld(rb, b11);
  st(ra, acc[1][0], b10);
  st(rb, acc[1][1], b11);
}

template <int EPI>
DI void gemm8_epilogue(const GemmArgs& g, f32x4 (&acc)[2][2][4][2], const int brow, const int bcol, const int wr, const int wc, const int fr, const int fq) {
#pragma unroll
  for (int ai = 0; ai < 2; ++ai) {
#pragma unroll
    for (int bj = 0; bj < 2; ++bj) {
      const int cb = bcol + bj * 128 + wc * 32;
      const int r0 = brow + ai * 128 + wr * 64 + fr;
      if constexpr (EPI == EPI_SWIGLU) {
        bf16_t* H = (bf16_t*)g.out0;
        const int hc = (cb >> 1) + fq * 4;
#pragma unroll
        for (int m = 0; m < 4; ++m) {
          float v[4];
#pragma unroll
          for (int j = 0; j < 4; ++j) { const float gt = acc[ai][bj][m][0][j], up = acc[ai][bj][m][1][j]; v[j] = gt * up * __builtin_amdgcn_rcpf(1.f + __expf(-gt)); }
          u32x2 o; o.x = pack2(v[0], v[1]); o.y = pack2(v[2], v[3]);
          *(u32x2*)&H[(size_t)(r0 + m * 16) * DFF + hc] = o;
        }
      } else if constexpr (EPI == EPI_RESID) {
        float* X = (float*)g.out0;
        const float* __restrict__ src = g.src;
        const size_t ibase = (size_t)r0 * DM + cb + fq * 4;
        f32x4 rr[4][2];
#pragma unroll
        for (int m = 0; m < 4; ++m)
#pragma unroll
          for (int n = 0; n < 2; ++n) rr[m][n] = *(const f32x4*)(src + ibase + (size_t)(m * 16) * DM + n * 16);
#pragma unroll
        for (int m = 0; m < 4; ++m)
#pragma unroll
          for (int n = 0; n < 2; ++n) {
            f32x4 o;
            o.x = rr[m][n].x + g.scale * acc[ai][bj][m][n][0]; o.y = rr[m][n].y + g.scale * acc[ai][bj][m][n][1];
            o.z = rr[m][n].z + g.scale * acc[ai][bj][m][n][2]; o.w = rr[m][n].w + g.scale * acc[ai][bj][m][n][3];
            *(f32x4*)(X + ibase + (size_t)(m * 16) * DM + n * 16) = o;
          }
      } else if constexpr (EPI == EPI_PROJ_EVEN) {
        if ((bcol == 2304 || bcol == 2560) && bj == 1) {
          bf16_t* VT = (bf16_t*)(bcol == 2304 ? g.out1 : g.out2);
#pragma unroll
          for (int m = 0; m < 4; ++m) {
            const int row = r0 + m * 16, b = row >> 12, t = row & 4095;
#pragma unroll
            for (int n = 0; n < 2; ++n)
#pragma unroll
              for (int j = 0; j < 4; ++j) {
                const int d = wc * 32 + n * 16 + fq * 4 + j;
                VT[((size_t)((b * 2 + (d >> 6)) * 64 + (d & 63))) * SEQ + t] = f2bf(acc[ai][bj][m][n][j]);
              }
          }
        } else {
          bf16_t* P = (bf16_t*)g.out0;
#pragma unroll
          for (int n = 0; n < 2; ++n) {
            const int col = cb + n * 16 + fq * 4;
            if (col < 2840) {
#pragma unroll
              for (int m = 0; m < 4; ++m) {
                u32x2 o; o.x = pack2(acc[ai][bj][m][n][0], acc[ai][bj][m][n][1]); o.y = pack2(acc[ai][bj][m][n][2], acc[ai][bj][m][n][3]);
                *(u32x2*)&P[(size_t)(r0 + m * 16) * LDP_E + col] = o;
              }
            }
          }
        }
      } else {
        if (bcol >= 2048) {
          bf16_t* VT = (bf16_t*)g.out1;
#pragma unroll
          for (int m = 0; m < 4; ++m) {
            const int row = r0 + m * 16, b = row >> 12, t = row & 4095;
#pragma unroll
            for (int n = 0; n < 2; ++n)
#pragma unroll
              for (int j = 0; j < 4; ++j) {
                const int c = cb - 2048 + n * 16 + fq * 4 + j;
                VT[((size_t)((b * 16 + (c >> 6)) * 64 + (c & 63))) * SEQ + t] = f2bf(acc[ai][bj][m][n][j]);
              }
          }
        } else {
          bf16_t* P = (bf16_t*)g.out0;
#pragma unroll
          for (int n = 0; n < 2; ++n) {
            const int col = cb + n * 16 + fq * 4;
#pragma unroll
            for (int m = 0; m < 4; ++m) {
              u32x2 o; o.x = pack2(acc[ai][bj][m][n][0], acc[ai][bj][m][n][1]); o.y = pack2(acc[ai][bj][m][n][2], acc[ai][bj][m][n][3]);
              *(u32x2*)&P[(size_t)(r0 + m * 16) * LDP_O + col] = o;
            }
          }
        }
      }
    }
  }
}

template <int EPI, bool ALIGN_EPI = true, bool SP2 = true>
DI void gemm8_phase(const GemmArgs& g, char* lds_) {
  using namespace g8;
  LAS unsigned char* lds = (LAS unsigned char*)lds_;
  const int tid = otid();
  const int wid = __builtin_amdgcn_readfirstlane(tid >> 6), lane = tid & 63, wr = wid >> 2, wc = wid & 3, fr = lane & 15, fq = lane >> 4;
  constexpr bool TRANSPOSED = true;
  constexpr int EPI_VM = 0;
  const int K = g.K, nt = K / BK;
  const int total = g.NTm * g.NTn, G = gridDim.x;
  if ((int)blockIdx.x >= total) return;
  unsigned voff[2];
#pragma unroll
  for (int i = 0; i < 2; ++i) { int R, C; stage_rc(tid * 16 + i * 8192, R, C); voff[i] = (unsigned)(R * K + C) * 2u; }
  const size_t kstep = (size_t)(BK * 2);
  const size_t hstep = (size_t)HALF * K * 2;
  const size_t tstep = 2 * hstep;
  const unsigned ldsw = (unsigned)wid * 1024u;
  const int aoff = lds_byte(wr * 64 + fr, fq * 8), boff = lds_byte(wc * 32 + fr, fq * 8);
  constexpr int HTB = HT * 2;
#define PG8_SA(b, h) (((b) * 2 + (h)) * HTB)
#define PG8_SB(b, h) ((4 + (b) * 2 + (h)) * HTB)
#define PG8_STAGE(bufoff, gbase) do { _Pragma("unroll") for (int _i = 0; _i < 2; ++_i) \
    __builtin_amdgcn_global_load_lds((const unsigned*)((const char*)(gbase) + voff[_i]), (LAS unsigned*)(lds + (bufoff) + ldsw + _i * 8192), 16, 0, 0); } while (0)
#define PG8_LDA(dst, b, h) do { _Pragma("unroll") for (int m = 0; m < 4; ++m) _Pragma("unroll") for (int k = 0; k < 2; ++k) dst[m][k] = *(const LAS bf16x8*)(lds + PG8_SA(b, h) + aoff + m * 2048 + k * 1024); } while (0)
#define PG8_LDB(dst, b, h) do { _Pragma("unroll") for (int n = 0; n < 2; ++n) _Pragma("unroll") for (int k = 0; k < 2; ++k) dst[n][k] = *(const LAS bf16x8*)(lds + PG8_SB(b, h) + boff + n * 2048 + k * 1024); } while (0)
#define PG8_MMA(ai, bj, At_, Bt_) do { __builtin_amdgcn_s_setprio(1); _Pragma("unroll") for (int m = 0; m < 4; ++m) _Pragma("unroll") for (int n = 0; n < 2; ++n) _Pragma("unroll") for (int k = 0; k < 2; ++k) \
    acc[ai][bj][m][n] = TRANSPOSED ? __builtin_amdgcn_mfma_f32_16x16x32_bf16(Bt_[n][k], At_[m][k], acc[ai][bj][m][n], 0, 0, 0) \
                                   : __builtin_amdgcn_mfma_f32_16x16x32_bf16(At_[m][k], Bt_[n][k], acc[ai][bj][m][n], 0, 0, 0); __builtin_amdgcn_s_setprio(0); } while (0)
#define PG8_WAIT_V(n) asm volatile("s_waitcnt vmcnt(" #n ")" ::: "memory")
#define PG8_WAIT_L(n) asm volatile("s_waitcnt lgkmcnt(" #n ")" ::: "memory")
#define PG8_BAR __builtin_amdgcn_s_barrier()
#define PG8_SCHED __builtin_amdgcn_sched_barrier(0)
  int ui = 0, cpm, cpn, npm = 0, npn = 0;
  tile_map(blockIdx.x, g.NTm, g.NTn, cpm, cpn, g.gm);
  f32x4 acc[2][2][4][2];
#pragma unroll
  for (int a = 0; a < 2; ++a)
#pragma unroll
    for (int b = 0; b < 2; ++b)
#pragma unroll
      for (int m = 0; m < 4; ++m)
#pragma unroll
        for (int n = 0; n < 2; ++n) acc[a][b][m][n] = f32x4{0.f, 0.f, 0.f, 0.f};
  bf16x8 At[4][2], B0[2][2], B1[2][2];
  const char* cA = (const char*)g.A0 + (size_t)cpm * tstep;
  const char* cB = (const char*)g.Bt0 + (size_t)cpn * tstep;
  PG8_WAIT_V(0);
  __syncthreads();
  if constexpr (SP2) {
    PG8_STAGE(PG8_SB(0, 0), cB); PG8_STAGE(PG8_SB(0, 1), cB + hstep); PG8_STAGE(PG8_SA(0, 0), cA); PG8_STAGE(PG8_SA(0, 1), cA + hstep);
    if (wr == 1) PG8_BAR;
    PG8_WAIT_V(2); PG8_BAR;
    PG8_STAGE(PG8_SB(1, 0), cB + kstep); PG8_STAGE(PG8_SA(1, 0), cA + kstep); PG8_STAGE(PG8_SB(1, 1), cB + hstep + kstep);
    PG8_WAIT_V(6); PG8_BAR;
  } else {
    PG8_STAGE(PG8_SB(0, 0), cB); PG8_STAGE(PG8_SA(0, 0), cA); PG8_STAGE(PG8_SB(0, 1), cB + hstep); PG8_STAGE(PG8_SA(0, 1), cA + hstep);
    if (wr == 1) PG8_BAR;
    PG8_WAIT_V(4); PG8_BAR;
    PG8_STAGE(PG8_SB(1, 0), cB + kstep); PG8_STAGE(PG8_SA(1, 0), cA + kstep); PG8_STAGE(PG8_SB(1, 1), cB + hstep + kstep);
    PG8_WAIT_V(6); PG8_BAR;
  }
  for (;;) {
    const int nid = (int)blockIdx.x + (ui + 1) * G;
    const bool has_next = nid < total;
    if (has_next) tile_map(nid, g.NTm, g.NTn, npm, npn, g.gm);
    const char* nA = has_next ? (const char*)g.A0 + (size_t)npm * tstep : cA;
    const char* nB = has_next ? (const char*)g.Bt0 + (size_t)npn * tstep : cB;
#pragma unroll 1
    for (int t = 0; t < nt; t += 2) {
      const bool last = (t == nt - 2);
      const char* a1 = cA + (size_t)(t + 1) * kstep;
      const char* a2 = last ? nA : cA + (size_t)(t + 2) * kstep;
      const char* b2 = last ? nB : cB + (size_t)(t + 2) * kstep;
      const char* a3 = a2 + kstep; const char* b3 = b2 + kstep;
      if constexpr (SP2) {
        const bool relax = EPI_VM > 0 && t == 0 && ui > 0;
        PG8_LDB(B0, 0, 0); PG8_LDB(B1, 0, 1); PG8_SCHED; PG8_LDA(At, 0, 0); PG8_STAGE(PG8_SA(1, 1), a1 + hstep);
        if (relax) PG8_WAIT_V(24); else PG8_WAIT_V(8);
        PG8_WAIT_L(0); PG8_BAR; PG8_MMA(0, 0, At, B0); PG8_MMA(0, 1, At, B1); PG8_BAR; PG8_SCHED;
        PG8_LDA(At, 0, 1); PG8_STAGE(PG8_SB(0, 0), b2); PG8_STAGE(PG8_SB(0, 1), b2 + hstep); PG8_STAGE(PG8_SA(0, 0), a2);
        if (relax) PG8_WAIT_V(24); else PG8_WAIT_V(8);
        PG8_WAIT_L(0); PG8_BAR; PG8_MMA(1, 0, At, B0); PG8_MMA(1, 1, At, B1); PG8_BAR; PG8_SCHED;
        PG8_LDB(B0, 1, 0); PG8_LDB(B1, 1, 1); PG8_SCHED; PG8_LDA(At, 1, 0); PG8_STAGE(PG8_SA(0, 1), a2 + hstep);
        PG8_WAIT_V(8); PG8_WAIT_L(0); PG8_BAR; PG8_MMA(0, 0, At, B0); PG8_MMA(0, 1, At, B1); PG8_BAR; PG8_SCHED;
        PG8_LDA(At, 1, 1); PG8_STAGE(PG8_SB(1, 0), b3); PG8_STAGE(PG8_SB(1, 1), b3 + hstep); PG8_STAGE(PG8_SA(1, 0), a3);
        PG8_WAIT_V(8); PG8_WAIT_L(0); PG8_BAR; PG8_MMA(1, 0, At, B0); PG8_MMA(1, 1, At, B1); PG8_BAR; PG8_SCHED;
      } else {
        PG8_LDB(B0, 0, 0); PG8_SCHED; PG8_LDA(At, 0, 0); PG8_STAGE(PG8_SA(1, 1), a1 + hstep);
        PG8_WAIT_L(8); PG8_BAR; PG8_WAIT_L(0); PG8_MMA(0, 0, At, B0); PG8_BAR; PG8_SCHED;
        PG8_LDB(B1, 0, 1); PG8_STAGE(PG8_SB(0, 0), b2);
        PG8_BAR; PG8_WAIT_L(0); PG8_MMA(0, 1, At, B1); PG8_BAR;
        PG8_LDA(At, 0, 1); PG8_STAGE(PG8_SA(0, 0), a2);
        PG8_BAR; PG8_WAIT_L(0); PG8_MMA(1, 0, At, B0); PG8_BAR; PG8_SCHED;
        PG8_STAGE(PG8_SB(0, 1), b2 + hstep);
        PG8_WAIT_V(6); PG8_BAR; PG8_MMA(1, 1, At, B1); PG8_BAR;
        PG8_LDB(B0, 1, 0); PG8_SCHED; PG8_LDA(At, 1, 0); PG8_STAGE(PG8_SA(0, 1), a2 + hstep);
        PG8_WAIT_L(8); PG8_BAR; PG8_WAIT_L(0); PG8_MMA(0, 0, At, B0); PG8_BAR; PG8_SCHED;
        PG8_LDB(B1, 1, 1); PG8_STAGE(PG8_SB(1, 0), b3);
        PG8_BAR; PG8_WAIT_L(0); PG8_MMA(0, 1, At, B1); PG8_BAR;
        PG8_LDA(At, 1, 1); PG8_STAGE(PG8_SA(1, 0), a3);
        PG8_BAR; PG8_WAIT_L(0); PG8_MMA(1, 0, At, B0); PG8_BAR; PG8_SCHED;
        PG8_STAGE(PG8_SB(1, 1), b3 + hstep);
        PG8_WAIT_V(6); PG8_BAR; PG8_MMA(1, 1, At, B1); PG8_BAR;
      }
    }
    if constexpr (ALIGN_EPI) { if (wr == 0) PG8_BAR; }
    if constexpr (EPI == EPI_RESID) gemm8_resid_epilogue(g, acc, cpm * 256, cpn * 256, wr, wc, fr, fq);
    else gemm8_epilogue<EPI>(g, acc, cpm * 256, cpn * 256, wr, wc, fr, fq);
    if (!has_next) break;
#pragma unroll
    for (int a = 0; a < 2; ++a)
#pragma unroll
      for (int b = 0; b < 2; ++b)
#pragma unroll
        for (int m = 0; m < 4; ++m)
#pragma unroll
          for (int n = 0; n < 2; ++n) acc[a][b][m][n] = f32x4{0.f, 0.f, 0.f, 0.f};
    cpm = npm; cpn = npn; cA = nA; cB = nB; ++ui;
    if constexpr (ALIGN_EPI) { if (wr == 1) PG8_BAR; }
  }
  PG8_WAIT_V(0);
  if constexpr (!ALIGN_EPI) { if (wr == 0) PG8_BAR; }
  PG8_BAR;
#undef PG8_SA
#undef PG8_SB
#undef PG8_STAGE
#undef PG8_LDA
#undef PG8_LDB
#undef PG8_MMA
#undef PG8_WAIT_V
#undef PG8_WAIT_L
#undef PG8_BAR
#undef PG8_SCHED
}

#define PH_BEGIN if (ph >= p.ph_lo && ph < p.ph_hi) {
#define PH_END   if (ph + 1 < p.ph_hi) { if (p.ph_hi < 0) grid.sync(); else xcd_barrier(xb); } } ++ph;

__global__ void __launch_bounds__(512, 2) fwd_megakernel(Params p) {
  __shared__ __attribute__((aligned(16))) char lds[LDS_BYTES + 64];
  cg::grid_group grid = cg::this_grid();
  unsigned char* ws = p.ws;
  if (threadIdx.x < 16) ((unsigned*)(lds + LDS_BYTES))[threadIdx.x] = 0u;
  __syncthreads();
  XcdBarrier xb = xcd_barrier_post((unsigned*)(ws + OFF_BAR), (volatile LAS unsigned*)(LAS char*)(lds + LDS_BYTES));
  bf16_t* XB = (bf16_t*)(ws + OFF_XB);
  bf16_t* Yb = (bf16_t*)(ws + OFF_Y);
  bf16_t* R = (bf16_t*)(ws + OFF_R);
  float* X = p.X;
  int ph = 0;

  PH_BEGIN
    prep_phase(p, lds);
    rownorm_phase(p.in[0], XB);
  PH_END

#pragma unroll 1
  for (int step = 0; step < 12; ++step) {
    const int l = step / 3, s = step - 3 * l;
    GemmArgs ra{};
    ra.NTm = 128; ra.NTn = 4; ra.nmat = 1; ra.gm = 4; ra.out0 = X; ra.src = (step == 0) ? p.in[0] : X;
    if (s != 1) {
      const int f = s >> 1;
      PH_BEGIN
        GemmArgs ga{};
        ga.A0 = XB; ga.lda = DM; ga.Bt0 = w_ffn_in(ws, l, f); ga.K = DM; ga.NTm = 128; ga.NTn = 22; ga.nmat = 1; ga.gm = 4; ga.out0 = R;
        gemm8_phase<EPI_SWIGLU>(ga, lds);
      PH_END
      ra.A0 = R; ra.lda = DFF; ra.K = DFF; ra.Bt0 = w_ffn_out(ws, l, f); ra.scale = 0.5f; ra.gm = 2;
    } else if ((l & 1) == 0) {
      const int i = l >> 1;
      bf16_t* VTS = (bf16_t*)(ws + OFF_VTS);
      bf16_t* VTW = (bf16_t*)(ws + OFF_VTW);
      bf16_t* HC = (bf16_t*)(ws + OFF_HC);
      bf16_t* KC = (bf16_t*)(ws + OFF_KC);
      bf16_t* VCT = (bf16_t*)(ws + OFF_VCT);
      PH_BEGIN
        GemmArgs ga{};
        ga.A0 = XB; ga.lda = DM; ga.Bt0 = w_ab(ws, i); ga.K = DM; ga.NTm = 128; ga.NTn = 12; ga.nmat = 1; ga.gm = 4;
        ga.out0 = R; ga.out1 = VTS; ga.out2 = VTW;
        gemm8_phase<EPI_PROJ_EVEN>(ga, lds);
      PH_END
      PH_BEGIN
        GemmArgs ga{};
        ga.A0 = R; ga.A1 = R; ga.aoff0 = 2048; ga.aoff1 = 2176; ga.Bt0 = w_c1(ws, i, 0); ga.Bt1 = w_c1(ws, i, 1);
        ga.K = 2048; ga.NTm = 32; ga.NTn = 1; ga.nmat = 2; ga.out0 = HC; ga.out1 = HC + 4096 * 128;
        ga.bias0 = (const float*)(ws + OFF_BIAS) + (i * 2 + 0) * 128; ga.bias1 = (const float*)(ws + OFF_BIAS) + (i * 2 + 1) * 128;
        const float* cw = p.in[6] + (size_t)i * 3 * 512;
        const int hf = otid() >> 8;
        for (int id = blockIdx.x; id < 64 + 512; id += gridDim.x) {
          if (id < 64) {
            const int kv = id >> 5; int mt, nt; tile_map(id & 31, 32, 1, mt, nt);
            gemm_tile<EPI_CMP1>(ga, kv, mt, nt, lds + hf * GEMM_LDS, hf * 16, hf * 16 + 16, (float*)(lds + GEMM_LDS), hf);
          } else {
            conv_item(R, cw, Yb, (id - 64) * 2 + hf);
          }
        }
      PH_END
      PH_BEGIN
        GemmArgs ga{};
        ga.A0 = HC; ga.A1 = HC + 4096 * 128; ga.lda = 128; ga.Bt0 = w_c2(ws, i, 0); ga.Bt1 = w_c2(ws, i, 1);
        ga.K = 128; ga.NTm = 32; ga.NTn = 1; ga.nmat = 2; ga.out0 = KC; ga.out1 = VCT;
        gemm_pair_phase<EPI_CMP2>(ga, lds);
      PH_END
      PH_BEGIN
        for (int it = blockIdx.x; it < 1024; it += gridDim.x) nsa_item(R, KC, VCT, VTS, VTW, Yb, it, lds);
      PH_END
      ra.A0 = Yb; ra.lda = DM; ra.K = DM; ra.Bt0 = w_abo(ws, i); ra.scale = 1.f;
    } else {
      const int i = l >> 1;
      bf16_t* VTO = (bf16_t*)(ws + OFF_VTO);
      PH_BEGIN
        GemmArgs ga{};
        ga.A0 = XB; ga.lda = DM; ga.Bt0 = w_qkv(ws, i); ga.K = DM; ga.NTm = 128; ga.NTn = 12; ga.nmat = 1; ga.gm = 4;
        ga.out0 = R; ga.out1 = VTO;
        gemm8_phase<EPI_PROJ_ODD>(ga, lds);
      PH_END
      PH_BEGIN
        for (int it = blockIdx.x; it < 2048; it += gridDim.x) sb_item(R, VTO, Yb, it, lds);
      PH_END
      ra.A0 = Yb; ra.lda = DM; ra.K = DM; ra.Bt0 = w_sbo(ws, i); ra.scale = 1.f;
    }
    PH_BEGIN
      gemm8_phase<EPI_RESID, false>(ra, lds);
    PH_END
    PH_BEGIN
      if (step < 11) rownorm_phase(X, XB);
      else finalnorm_phase(X, p.in[19]);
    PH_END
  }
}

extern "C" void kernel_launch(void* const* d_in, const int* in_sizes, int n_in, void* d_out, int out_size, void* d_ws, size_t ws_size,
                              hipStream_t stream) {
  static int grid_blocks = 0;
  if (!grid_blocks) {
    int dev = 0, cus = 0, per_cu = 0;
    (void)hipGetDevice(&dev);
    (void)hipDeviceGetAttribute(&cus, hipDeviceAttributeMultiprocessorCount, dev);
    (void)hipOccupancyMaxActiveBlocksPerMultiprocessor(&per_cu, fwd_megakernel, 512, 0);
    if (per_cu != 1) fprintf(stderr, "kernel_launch: occupancy query says %d blocks/CU; launching 1 per CU\n", per_cu);
    grid_blocks = cus;
    if (ws_size < WS_END) fprintf(stderr, "kernel_launch: workspace too small: %zu < %zu\n", ws_size, (size_t)WS_END);
    if (n_in != 20 || out_size != NT * DM) fprintf(stderr, "kernel_launch: unexpected shapes n_in=%d out=%d\n", n_in, out_size);
  }
  (void)hipMemsetAsync((char*)d_ws + OFF_BAR, 0, XCD_BAR_WORDS * 4, stream);
  Params p{};
  for (int i = 0; i < 20; ++i) p.in[i] = (const float*)d_in[i];
  p.X = (float*)d_out;
  p.ws = (unsigned char*)d_ws;
  p.ph_lo = 0; p.ph_hi = 1 << 20;
  void* args[] = {&p};
  hipError_t e = hipLaunchCooperativeKernel((void*)fwd_megakernel, dim3(grid_blocks), dim3(512), args, 0, stream);
  if (e != hipSuccess) fprintf(stderr, "cooperative launch failed: %s (grid %d)\n", hipGetErrorString(e), grid_blocks);
}
```
